# Optimizing an MI355X kernel written in HIP

```python
import math
import jax, jax.numpy as jnp
from jax import lax
import numpy as np

D_MODEL = 2048
BATCH = 1
SEQ = 8192
DEPTH = 1
DEC_BATCH = 16
DEC_SEQ = 64
PAST_LEN = 4096

CHUNK = 64
SSD_EXPAND = 2
SSD_INNER = SSD_EXPAND * D_MODEL
SSD_HEADDIM = 64
SSD_HEADS = SSD_INNER // SSD_HEADDIM
SSD_GROUPS = 8
SSD_HPG = SSD_HEADS // SSD_GROUPS
SSD_STATE = 128
CONV_W = 4
CONV_DIM = SSD_INNER + 2 * SSD_GROUPS * SSD_STATE
ATT_HEADS = 16
ATT_HEAD_DIM = 128
ATT_WIDTH = ATT_HEADS * ATT_HEAD_DIM
BAND_CHUNKS = 8
BAND_PAST = BAND_CHUNKS * CHUNK
BAND_LEN = BAND_PAST + CHUNK
REL_CLIP = 128
N_REL = 2 * REL_CLIP + 1
N_BRANCH = 2
D_FF = -(-(8 * D_MODEL) // (3 * 256)) * 256
LN_EPS = 1e-5
RMS_EPS = 1e-5
ALPHA = (2.0 * DEPTH) ** 0.25
BETA = (8.0 * DEPTH) ** -0.25
_SEG = (SSD_INNER, CONV_DIM, SSD_HEADS, ATT_WIDTH, ATT_WIDTH, ATT_WIDTH, N_BRANCH * D_MODEL)
IN_COLS = sum(_SEG)
SPLITS = tuple(int(v) for v in np.cumsum(_SEG)[:-1])

kernel_name = 'hybrid_ssd_bandattn_streaming_encoder'


def layer_norm(x, g, b):
    xf = x.astype(jnp.float32)
    mu = jnp.mean(xf, axis=-1, keepdims=True)
    var = jnp.mean(jnp.square(xf - mu), axis=-1, keepdims=True)
    y = (xf - mu) * lax.rsqrt(var + LN_EPS) * g.astype(jnp.float32) + b.astype(jnp.float32)
    return y.astype(x.dtype)


def causal_dwconv(u, hist, w, b):
    L = u.shape[1]
    up = jnp.concatenate([hist.astype(u.dtype), u], axis=1)
    y = b
    for tap in range(CONV_W):
        y = y + up[:, tap:tap + L] * w[tap]
    return y, up[:, L:]


def ssd_scan(x, dt, a, bm, cm, h0, q):
    b, l = x.shape[:2]
    c = l // q
    G, R, P, N = SSD_GROUPS, SSD_HPG, SSD_HEADDIM, SSD_STATE
    x = x.reshape(b, c, q, G, R, P)
    dt = dt.reshape(b, c, q, G, R)
    bm = bm.reshape(b, c, q, G, N)
    cm = cm.reshape(b, c, q, G, N)
    cs = jnp.cumsum(dt * a.reshape(G, R), axis=2)
    diff = cs[:, :, :, None] - cs[:, :, None, :]
    causal = jnp.tril(jnp.ones((q, q), dtype=bool))[:, :, None, None]
    decay_ij = jnp.exp(jnp.where(causal, diff, -jnp.inf))
    cb = jnp.einsum('bcign,bcjgn->bcijg', cm, bm)
    m = cb[..., None] * decay_ij * dt[:, :, None]
    y_diag = jnp.einsum('bcijgr,bcjgrp->bcigrp', m, x)
    decay_out = jnp.exp(cs[:, :, -1:] - cs)
    chunk_states = jnp.einsum('bcjgn,bcjgr,bcjgrp->bcgrpn', bm, decay_out * dt, x)
    chunk_decay = jnp.exp(cs[:, :, -1])

    def step(h, inp):
        s, d = inp
        return h * d[..., None, None] + s, h

    h_final, h_prev = lax.scan(step, h0.reshape(b, G, R, P, N),
                               (jnp.swapaxes(chunk_states, 0, 1), jnp.swapaxes(chunk_decay, 0, 1)))
    h_prev = jnp.swapaxes(h_prev, 0, 1)
    y_off = jnp.einsum('bcign,bcgrpn,bcigr->bcigrp', cm, h_prev, jnp.exp(cs))
    y = (y_diag + y_off).reshape(b, l, SSD_HEADS, P)
    return y, h_final.reshape(b, SSD_HEADS, P, N)


def ssd_branch(z, xbc, dt_raw, conv_hist, h0, conv_w, conv_b, dt_bias, a_log, d_skip, norm_w):
    bsz, L = z.shape[:2]
    xbc, conv_new = causal_dwconv(xbc, conv_hist, conv_w, conv_b)
    xbc = jax.nn.silu(xbc).astype(jnp.float32)
    xs, bm, cm = jnp.split(xbc, [SSD_INNER, SSD_INNER + SSD_GROUPS * SSD_STATE], axis=-1)
    xs = xs.reshape(bsz, L, SSD_HEADS, SSD_HEADDIM)
    bm = bm.reshape(bsz, L, SSD_GROUPS, SSD_STATE)
    cm = cm.reshape(bsz, L, SSD_GROUPS, SSD_STATE)
    dt = jax.nn.softplus(dt_raw.astype(jnp.float32) + dt_bias.astype(jnp.float32))
    a = -jnp.exp(a_log.astype(jnp.float32))
    y, h_new = ssd_scan(xs, dt, a, bm, cm, h0.astype(jnp.float32), min(CHUNK, L))
    y = (y + d_skip.astype(jnp.float32)[:, None] * xs).reshape(bsz, L, SSD_INNER)
    g = (y * jax.nn.silu(z.astype(jnp.float32))).reshape(bsz, L, SSD_GROUPS, SSD_INNER // SSD_GROUPS)
    g = g * lax.rsqrt(jnp.mean(jnp.square(g), axis=-1, keepdims=True) + RMS_EPS)
    out = g.reshape(bsz, L, SSD_INNER) * norm_w.astype(jnp.float32)
    return out.astype(z.dtype), conv_new, h_new.astype(h0.dtype)


def rel_position_bias(rel_bias, rel):
    return rel_bias[:, jnp.clip(rel, -REL_CLIP, REL_CLIP) + REL_CLIP].astype(jnp.float32)


def band_softmax_attention(q, kb, vb, bias, mask):
    s = jnp.einsum('bnqhd,bnkhd->bnhqk', q, kb).astype(jnp.float32) * (ATT_HEAD_DIM ** -0.5) + bias
    if mask is not None:
        s = jnp.where(mask[None, :, None], s, -jnp.inf)
    p = jax.nn.softmax(s, axis=-1).astype(vb.dtype)
    return jnp.einsum('bnhqk,bnkhd->bnqhd', p, vb)


def prompt_band_attention(q, k, v, rel_bias):
    b, S = q.shape[:2]
    nc = S // CHUNK
    pad = jnp.zeros((b, BAND_PAST, ATT_HEADS, ATT_HEAD_DIM), k.dtype)
    kp = jnp.concatenate([pad, k], axis=1)
    vp = jnp.concatenate([pad, v], axis=1)
    idx = (jnp.arange(nc) * CHUNK)[:, None] + jnp.arange(BAND_LEN)[None, :]
    kb = kp[:, idx]
    vb = vp[:, idx]
    mask = (idx >= BAND_PAST)[:, None, :]
    rel = jnp.arange(CHUNK)[:, None] - jnp.arange(BAND_LEN)[None, :] + BAND_PAST
    out = band_softmax_attention(q.reshape(b, nc, CHUNK, ATT_HEADS, ATT_HEAD_DIM), kb, vb,
                                 rel_position_bias(rel_bias, rel), mask)
    return out.reshape(b, S, ATT_HEADS, ATT_HEAD_DIM)


def sample_band_attention(q, k, v, k_hist, v_hist, rel_bias):
    L = q.shape[1]
    pc = k_hist.shape[1]
    kb = jnp.concatenate([k_hist.astype(k.dtype), k], axis=1)[:, None]
    vb = jnp.concatenate([v_hist.astype(v.dtype), v], axis=1)[:, None]
    rel = jnp.arange(L)[:, None] - jnp.arange(pc + L)[None, :] + pc
    out = band_softmax_attention(q[:, None], kb, vb, rel_position_bias(rel_bias, rel), None)
    return out[:, 0]


def trunk_layer(x, conv_hist, ssm_h0, k_hist, v_hist, w_in, conv_w, conv_b, dt_bias, a_log, d_skip,
                ssd_norm_w, rel_bias, w_ssd_out, w_att_out, w_o, ln1_g, ln1_b, w_gate_up, w_down,
                ln2_g, ln2_b):
    bsz, L = x.shape[:2]
    proj = x @ w_in
    z, xbc, dt_raw, q, k, v, gates = jnp.split(proj, SPLITS, axis=-1)
    ssd_y, conv_new, h_new = ssd_branch(z, xbc, dt_raw, conv_hist, ssm_h0, conv_w, conv_b,
                                        dt_bias, a_log, d_skip, ssd_norm_w)
    q = q.reshape(bsz, L, ATT_HEADS, ATT_HEAD_DIM)
    k = k.reshape(bsz, L, ATT_HEADS, ATT_HEAD_DIM)
    v = v.reshape(bsz, L, ATT_HEADS, ATT_HEAD_DIM)
    if k_hist is None:
        att = prompt_band_attention(q, k, v, rel_bias)
        keep = min(BAND_PAST, L)
        k_rows, v_rows = k[:, L - keep:], v[:, L - keep:]
    else:
        att = sample_band_attention(q, k, v, k_hist, v_hist, rel_bias)
        k_rows, v_rows = k, v
    att = att.reshape(bsz, L, ATT_WIDTH)
    g_ssd, g_att = jnp.split(jax.nn.sigmoid(gates), N_BRANCH, axis=-1)
    mixed = g_ssd * (ssd_y @ w_ssd_out) + g_att * (att @ w_att_out)
    h = layer_norm(ALPHA * x + mixed @ w_o, ln1_g, ln1_b)
    gate, up = jnp.split(h @ w_gate_up, 2, axis=-1)
    y = layer_norm(ALPHA * h + (jax.nn.silu(gate) * up) @ w_down, ln2_g, ln2_b)
    return y, conv_new, h_new, k_rows, v_rows


def setup_inputs(seed: int = 0) -> dict:
    key = jax.random.key(seed)
    ks = jax.random.split(key, 24)
    f32 = jnp.float32
    kv_rows = min(BAND_PAST, PAST_LEN)
    dt0 = jnp.exp(jax.random.uniform(ks[9], (DEPTH, SSD_HEADS), f32, math.log(1e-3), math.log(1e-1)))
    return {
        'x_prompt': jax.random.normal(ks[0], (BATCH, SEQ, D_MODEL), f32),
        'x_sample': jax.random.normal(ks[1], (DEC_BATCH, DEC_SEQ, D_MODEL), f32),
        'cache_k': jax.random.normal(ks[2], (DEPTH, DEC_BATCH, kv_rows, ATT_HEADS, ATT_HEAD_DIM), f32),
        'cache_v': jax.random.normal(ks[3], (DEPTH, DEC_BATCH, kv_rows, ATT_HEADS, ATT_HEAD_DIM), f32),
        'state_conv': jax.random.normal(ks[4], (DEPTH, DEC_BATCH, CONV_W - 1, CONV_DIM), f32),
        'state_ssm': 0.5 * jax.random.normal(ks[5], (DEPTH, DEC_BATCH, SSD_HEADS, SSD_HEADDIM, SSD_STATE), f32),
        'w_in': jax.random.normal(ks[6], (DEPTH, D_MODEL, IN_COLS), f32) * D_MODEL ** -0.5,
        'conv_w': jax.random.normal(ks[7], (DEPTH, CONV_W, CONV_DIM), f32) * CONV_W ** -0.5,
        'conv_b': 0.01 * jax.random.normal(ks[8], (DEPTH, CONV_DIM), f32),
        'dt_bias': dt0 + jnp.log(-jnp.expm1(-dt0)),
        'a_log': jnp.log(jax.random.uniform(ks[10], (DEPTH, SSD_HEADS), f32, 1.0, 16.0)),
        'd_skip': 1.0 + 0.1 * jax.random.normal(ks[11], (DEPTH, SSD_HEADS), f32),
        'ssd_norm_w': 1.0 + 0.05 * jax.random.normal(ks[12], (DEPTH, SSD_INNER), f32),
        'rel_bias': 0.5 * jax.random.normal(ks[13], (DEPTH, ATT_HEADS, N_REL), f32),
        'w_ssd_out': jax.random.normal(ks[14], (DEPTH, SSD_INNER, D_MODEL), f32) * SSD_INNER ** -0.5,
        'w_att_out': jax.random.normal(ks[15], (DEPTH, ATT_WIDTH, D_MODEL), f32) * ATT_WIDTH ** -0.5,
        'w_o': jax.random.normal(ks[16], (DEPTH, D_MODEL, D_MODEL), f32) * (BETA * D_MODEL ** -0.5),
        'ln1_g': 1.0 + 0.05 * jax.random.normal(ks[17], (DEPTH, D_MODEL), f32),
        'ln1_b': 0.01 * jax.random.normal(ks[18], (DEPTH, D_MODEL), f32),
        'w_gate_up': jax.random.normal(ks[19], (DEPTH, D_MODEL, 2 * D_FF), f32) * D_MODEL ** -0.5,
        'w_down': jax.random.normal(ks[20], (DEPTH, D_FF, D_MODEL), f32) * (BETA * D_FF ** -0.5),
        'ln2_g': 1.0 + 0.05 * jax.random.normal(ks[21], (DEPTH, D_MODEL), f32),
        'ln2_b': 0.01 * jax.random.normal(ks[22], (DEPTH, D_MODEL), f32),
    }


def reference(x_prompt, x_sample, cache_k, cache_v, state_conv, state_ssm, w_in, conv_w, conv_b,
              dt_bias, a_log, d_skip, ssd_norm_w, rel_bias, w_ssd_out, w_att_out, w_o, ln1_g, ln1_b,
              w_gate_up, w_down, ln2_g, ln2_b):
    yp, ys = x_prompt, x_sample
    conv_p, ssm_p, k_p, v_p = [], [], [], []
    conv_s, ssm_s, k_s, v_s = [], [], [], []
    for layer in range(DEPTH):
        params = (w_in[layer], conv_w[layer], conv_b[layer], dt_bias[layer], a_log[layer], d_skip[layer],
                  ssd_norm_w[layer], rel_bias[layer], w_ssd_out[layer], w_att_out[layer], w_o[layer],
                  ln1_g[layer], ln1_b[layer], w_gate_up[layer], w_down[layer], ln2_g[layer], ln2_b[layer])
        zero_conv = jnp.zeros((yp.shape[0], CONV_W - 1, CONV_DIM), yp.dtype)
        zero_ssm = jnp.zeros((yp.shape[0], SSD_HEADS, SSD_HEADDIM, SSD_STATE), yp.dtype)
        yp, c, h, k, v = trunk_layer(yp, zero_conv, zero_ssm, None, None, *params)
        conv_p.append(c); ssm_p.append(h); k_p.append(k); v_p.append(v)
        ys, c, h, k, v = trunk_layer(ys, state_conv[layer], state_ssm[layer], cache_k[layer],
                                     cache_v[layer], *params)
        conv_s.append(c); ssm_s.append(h); k_s.append(k); v_s.append(v)
    return (yp, ys, jnp.stack(conv_p), jnp.stack(ssm_p), jnp.stack(k_p), jnp.stack(v_p),
            jnp.stack(conv_s), jnp.stack(ssm_s), jnp.stack(k_s), jnp.stack(v_s))
```

```cpp
#include <hip/hip_runtime.h>
#include <hip/hip_cooperative_groups.h>
#include <cstdio>
namespace cg = cooperative_groups;

#ifndef ONE_LAUNCH
#define ONE_LAUNCH 0
#endif

typedef unsigned short bf16_t;
typedef short bf16x8 __attribute__((ext_vector_type(8)));
typedef float f32x4 __attribute__((ext_vector_type(4)));
typedef unsigned u32x4 __attribute__((ext_vector_type(4)));
typedef unsigned u32x2 __attribute__((ext_vector_type(2)));

extern __shared__ __attribute__((aligned(16))) unsigned char g_lds[];

constexpr int MP = 8192, MS = 1024, MT = 9216, DM = 2048, SI = 4096, CD = 6144, DFF = 5632;
constexpr int NIN_SRC = 20544, NIN = 20736;
constexpr float ALPHA = 1.189207115002721f;
constexpr int NPH = 11;
constexpr int LDS_BYTES = 131072;
constexpr size_t O_YP = 0, O_CONVP = 18874368, O_SSMP = 18892800, O_KP = 19417088, O_VP = 20465664,
                 O_CONVS = 21514240, O_SSMS = 21809152, O_KS = 30197760, O_VS = 32294912;
constexpr size_t OFF_XB = 0, OFF_WIN = 37748736, OFF_XC = 0, OFF_ACT = 0;
constexpr size_t OFF_XBC = 122683392, OFF_Y = OFF_XBC, OFF_ATT = OFF_XBC + 75497472;
constexpr size_t OFF_Q = 235929600, OFF_KPB = 273678336, OFF_VPB = 307232768, OFF_KSB = 340787200, OFF_VSB = 378535936;
constexpr size_t OFF_WGU = OFF_Q, OFF_WDN = 282066944, OFF_MIXED = 305135616, OFF_HB = 342884352;
constexpr size_t OFF_Z = 416284672, OFF_H = OFF_Z, OFF_GT = 491782144, OFF_DT = 567279616;
constexpr size_t OFF_WSSD = 569638912, OFF_WATT = 586416128, OFF_WO = 594804736, WS_END = 603193344;

struct Params { const float* in[23]; float* out; unsigned char* ws; int ph_lo, ph_hi; };

__device__ __forceinline__ unsigned pk2(float lo, float hi) { unsigned r; asm volatile("v_cvt_pk_bf16_f32 %0, %1, %2" : "=v"(r) : "v"(lo), "v"(hi)); return r; }
__device__ __forceinline__ bf16_t f2bf(float f) { unsigned u = __float_as_uint(f); u += 0x7FFFu + ((u >> 16) & 1u); return (bf16_t)(u >> 16); }
__device__ __forceinline__ float bf2f(bf16_t b) { return __uint_as_float(((unsigned)b) << 16); }
__device__ __forceinline__ float lo2f(unsigned w) { return __uint_as_float(w << 16); }
__device__ __forceinline__ float hi2f(unsigned w) { return __uint_as_float(w & 0xffff0000u); }
__device__ __forceinline__ float fsig(float x) { return __builtin_amdgcn_rcpf(1.0f + __expf(-x)); }
__device__ __forceinline__ float fsilu(float x) { return x * fsig(x); }
__device__ __forceinline__ u32x4 cvt8(const float* s) {
    const f32x4 a = *(const f32x4*)s, b = *(const f32x4*)(s + 4);
    u32x4 r; r.x = pk2(a[0], a[1]); r.y = pk2(a[2], a[3]); r.z = pk2(b[0], b[1]); r.w = pk2(b[2], b[3]); return r;
}
__device__ __forceinline__ f32x4 mfma16(bf16x8 a, bf16x8 b, f32x4 c) { return __builtin_amdgcn_mfma_f32_16x16x32_bf16(a, b, c, 0, 0, 0); }

namespace pg8 {
#define PG8_LAS __attribute__((address_space(3)))
constexpr int BM = 256, BK = 64, HALF = 128, HTB = HALF * BK * 2, STAGE_BYTES = 8 * HTB, NXCD = 8, WGM = 8;
__host__ __device__ __forceinline__ int lds_byte(int r, int c) { const int st = (r >> 4) * 2 + (c >> 5), rr = r & 15, cc = c & 31, ob = rr * 64 + cc * 2; return st * 1024 + (ob ^ (((ob >> 9) & 1) << 5)); }
__host__ __device__ __forceinline__ void stage_rc(int b, int& R, int& C) { const int st = b / 1024, sb = b % 1024, swz = sb ^ (((sb >> 9) & 1) << 5); R = (st >> 1) * 16 + swz / 64; C = (st & 1) * 32 + (swz % 64) / 2; }
__host__ __device__ __forceinline__ int perm32(int rho) { const int n = rho >> 4, i = rho & 15; return 8 * (i >> 2) + 4 * n + (i & 3); }
struct Unit { int pm, pn; };
struct Gemm { const bf16_t* A; const bf16_t* Bt; int M, N, K; };
struct StaticOrder {
    int nM, nN, nwg, G, c;
    __host__ __device__ void init(int M, int N, int G_, int c_) { nM = M / BM; nN = N / BM; nwg = nM * nN; G = G_; c = c_; }
    __host__ __device__ bool next(int i, Unit& u) const {
        const long L = (long)i * G + c; if (L >= nwg) return false;
        int wgid = (int)L; { const int q = nwg / NXCD, r = nwg % NXCD, xcd = wgid % NXCD, off = wgid / NXCD; wgid = (xcd < r ? xcd * (q + 1) : r * (q + 1) + (xcd - r) * q) + off; }
        const int nig = WGM * nN, gid = wgid / nig, fm = gid * WGM, gsz = (nM - fm) < WGM ? (nM - fm) : WGM;
        u.pm = fm + ((wgid % nig) % gsz); u.pn = (wgid % nig) / gsz; return true;
    }
    __device__ __forceinline__ void a_ready(const Unit&) const {}
    __device__ __forceinline__ void done(const Unit&) const {}
};

template <class Epi, class Sched>
__device__ __forceinline__ void gemm_phase(PG8_LAS unsigned char* lds, const Gemm g, const Sched& S, const Epi& E) {
    const int tid = threadIdx.x, wid = __builtin_amdgcn_readfirstlane(tid >> 6), lane = tid & 63, wr = wid >> 2, wc = wid & 3, fr = lane & 15, fq = lane >> 4;
    const int K = g.K, nt = K / BK;
    unsigned voffA[2], voffB[2];
#pragma unroll
    for (int i = 0; i < 2; ++i) { int R, C; stage_rc(tid * 16 + i * 8192, R, C); const int Rb = Epi::PERM ? ((R & ~31) + perm32(R & 31)) : R;
        voffA[i] = (unsigned)(R * K + C) * 2u; voffB[i] = (unsigned)(Rb * K + C) * 2u; }
    const size_t kstep = (size_t)(BK * 2);
    const size_t hstep = (size_t)HALF * K * 2;
    const size_t tstep = 2 * hstep;
    const unsigned ldsw = (unsigned)wid * 1024u;
    const int aoff = lds_byte(wr * 64 + fr, fq * 8), boff = lds_byte(wc * 32 + fr, fq * 8);
#define PG8_SA(b, h) (((b) * 2 + (h)) * HTB)
#define PG8_SB(b, h) ((4 + (b) * 2 + (h)) * HTB)
#define PG8_STAGE(bufoff, gbase, voff) do { _Pragma("unroll") for (int _i = 0; _i < 2; ++_i) \
        __builtin_amdgcn_global_load_lds((const unsigned*)((const char*)(gbase) + (voff)[_i]), (PG8_LAS unsigned*)(lds + (bufoff) + ldsw + _i * 8192), 16, 0, 0); } while (0)
#define PG8_LDA(dst, b, h) do { _Pragma("unroll") for (int m = 0; m < 4; ++m) _Pragma("unroll") for (int k = 0; k < 2; ++k) dst[m][k] = *(const PG8_LAS bf16x8*)(lds + PG8_SA(b, h) + aoff + m * 2048 + k * 1024); } while (0)
#define PG8_LDB(dst, b, h) do { _Pragma("unroll") for (int n = 0; n < 2; ++n) _Pragma("unroll") for (int k = 0; k < 2; ++k) dst[n][k] = *(const PG8_LAS bf16x8*)(lds + PG8_SB(b, h) + boff + n * 2048 + k * 1024); } while (0)
#define PG8_MMA(ai, bj, At, Bt) do { __builtin_amdgcn_s_setprio(1); _Pragma("unroll") for (int m = 0; m < 4; ++m) _Pragma("unroll") for (int n = 0; n < 2; ++n) _Pragma("unroll") for (int k = 0; k < 2; ++k) \
        acc[ai][bj][m][n] = __builtin_amdgcn_mfma_f32_16x16x32_bf16(Bt[n][k], At[m][k], acc[ai][bj][m][n], 0, 0, 0); __builtin_amdgcn_s_setprio(0); } while (0)
#define PG8_WAIT_V(n) asm volatile("s_waitcnt vmcnt(" #n ")" ::: "memory")
#define PG8_WAIT_L(n) asm volatile("s_waitcnt lgkmcnt(" #n ")" ::: "memory")
#define PG8_BAR __builtin_amdgcn_s_barrier()
#define PG8_SCHED __builtin_amdgcn_sched_barrier(0)
    Unit cur, nxt; int ui = 0;
    if (!S.next(0, cur)) return;
    f32x4 acc[2][2][4][2];
#pragma unroll
    for (int a = 0; a < 2; ++a)
#pragma unroll
        for (int b = 0; b < 2; ++b)
#pragma unroll
            for (int m = 0; m < 4; ++m)
#pragma unroll
                for (int n = 0; n < 2; ++n) acc[a][b][m][n] = (f32x4){0.f, 0.f, 0.f, 0.f};
    bf16x8 At[4][2], B0[2][2], B1[2][2];
    const char* cA = (const char*)g.A + (size_t)cur.pm * tstep; const char* cB = (const char*)g.Bt + (size_t)cur.pn * tstep;
    S.a_ready(cur);
    PG8_STAGE(PG8_SB(0, 0), cB, voffB); PG8_STAGE(PG8_SA(0, 0), cA, voffA); PG8_STAGE(PG8_SB(0, 1), cB + hstep, voffB); PG8_STAGE(PG8_SA(0, 1), cA + hstep, voffA);
    if (wr == 1) PG8_BAR;
    PG8_WAIT_V(4); PG8_BAR;
    PG8_STAGE(PG8_SB(1, 0), cB + kstep, voffB); PG8_STAGE(PG8_SA(1, 0), cA + kstep, voffA); PG8_STAGE(PG8_SB(1, 1), cB + hstep + kstep, voffB);
    PG8_WAIT_V(6); PG8_BAR;
    for (;;) {
        const bool has_next = S.next(ui + 1, nxt);
        const char* nA = has_next ? (const char*)g.A + (size_t)nxt.pm * tstep : cA; const char* nB = has_next ? (const char*)g.Bt + (size_t)nxt.pn * tstep : cB;
        for (int t = 0; t < nt; t += 2) {
            const bool last = (t == nt - 2);
            const char* a1 = cA + (size_t)(t + 1) * kstep;
            const char* a2 = last ? nA : cA + (size_t)(t + 2) * kstep; const char* b2 = last ? nB : cB + (size_t)(t + 2) * kstep;
            const char* a3 = a2 + kstep; const char* b3 = b2 + kstep;
            if (last && has_next) S.a_ready(nxt);
            PG8_LDB(B0, 0, 0); PG8_SCHED; PG8_LDA(At, 0, 0); PG8_STAGE(PG8_SA(1, 1), a1 + hstep, voffA);
            PG8_WAIT_L(8); PG8_BAR; PG8_WAIT_L(0); PG8_MMA(0, 0, At, B0); PG8_BAR; PG8_SCHED;
            PG8_LDB(B1, 0, 1); PG8_STAGE(PG8_SB(0, 0), b2, voffB);
            PG8_BAR; PG8_WAIT_L(0); PG8_MMA(0, 1, At, B1); PG8_BAR;
            PG8_LDA(At, 0, 1); PG8_STAGE(PG8_SA(0, 0), a2, voffA);
            PG8_BAR; PG8_WAIT_L(0); PG8_MMA(1, 0, At, B0); PG8_BAR; PG8_SCHED;
            PG8_STAGE(PG8_SB(0, 1), b2 + hstep, voffB);
            PG8_WAIT_V(6); PG8_BAR; PG8_MMA(1, 1, At, B1); PG8_BAR;
            PG8_LDB(B0, 1, 0); PG8_SCHED; PG8_LDA(At, 1, 0); PG8_STAGE(PG8_SA(0, 1), a2 + hstep, voffA);
            PG8_WAIT_L(8); PG8_BAR; PG8_WAIT_L(0); PG8_MMA(0, 0, At, B0); PG8_BAR; PG8_SCHED;
            PG8_LDB(B1, 1, 1); PG8_STAGE(PG8_SB(1, 0), b3, voffB);
            PG8_BAR; PG8_WAIT_L(0); PG8_MMA(0, 1, At, B1); PG8_BAR;
            PG8_LDA(At, 1, 1); PG8_STAGE(PG8_SA(1, 0), a3, voffA);
            PG8_BAR; PG8_WAIT_L(0); PG8_MMA(1, 0, At, B0); PG8_BAR; PG8_SCHED;
            PG8_STAGE(PG8_SB(1, 1), b3 + hstep, voffB);
            PG8_WAIT_V(6); PG8_BAR; PG8_MMA(1, 1, At, B1); PG8_BAR;
        }
        E(acc, cur, wr, wc, fr, fq); S.done(cur);
        if (!has_next) break;
#pragma unroll
        for (int a = 0; a < 2; ++a)
#pragma unroll
            for (int b = 0; b < 2; ++b)
#pragma unroll
                for (int m = 0; m < 4; ++m)
#pragma unroll
                    for (int n = 0; n < 2; ++n) acc[a][b][m][n] = (f32x4){0.f, 0.f, 0.f, 0.f};
        cur = nxt; cA = nA; cB = nB; ++ui;
    }
    PG8_WAIT_V(0);
    if (wr == 0) PG8_BAR;
    PG8_BAR;
#undef PG8_SA
#undef PG8_SB
#undef PG8_STAGE
#undef PG8_LDA
#undef PG8_LDB
#undef PG8_MMA
#undef PG8_WAIT_V
#undef PG8_WAIT_L
#undef PG8_BAR
#undef PG8_SCHED
}
}
using pg8::Unit;

__device__ __forceinline__ u32x4 pack8(const f32x4 a, const f32x4 b) { u32x4 w; w.x = pk2(a[0], a[1]); w.y = pk2(a[2], a[3]); w.z = pk2(b[0], b[1]); w.w = pk2(b[2], b[3]); return w; }

struct EpiIn {
    static constexpr bool PERM = true;
    bf16_t *Z, *XBC, *Q, *KP, *VP, *KS, *VS, *GT; float* DT; float* out; const float* dt_bias;
    __device__ __forceinline__ void operator()(const f32x4 (&acc)[2][2][4][2], const Unit& u, int wr, int wc, int fr, int fq) const {
        const int pn = u.pn;
        const int rbase = u.pm * 256 + wr * 64 + fr, cl = wc * 32 + 8 * fq;
#pragma unroll
        for (int ai = 0; ai < 2; ++ai)
#pragma unroll
            for (int m = 0; m < 4; ++m) {
                const int row = rbase + ai * 128 + m * 16;
#pragma unroll
                for (int bj = 0; bj < 2; ++bj) {
                    const int cloc = cl + bj * 128;
                    f32x4 v0 = acc[ai][bj][m][0], v1 = acc[ai][bj][m][1];
                    if (pn < 16) {
                        *(u32x4*)(Z + (size_t)row * SI + pn * 256 + cloc) = pack8(v0, v1);
                    } else if (pn < 40) {
                        const int c = (pn - 16) * 256 + cloc;
                        *(u32x4*)(XBC + (size_t)row * CD + c) = pack8(v0, v1);
                        float* o = nullptr;
                        if (row < MP) { if (row >= MP - 3) o = out + O_CONVP + (size_t)(row - (MP - 3)) * CD + c; }
                        else { const int t = (row - MP) & 63, b = (row - MP) >> 6; if (t >= 61) o = out + O_CONVS + (size_t)(b * 3 + t - 61) * CD + c; }
                        if (o) { *(f32x4*)o = v0; *(f32x4*)(o + 4) = v1; }
                    } else if (pn < 48) {
                        *(u32x4*)(Q + (size_t)row * DM + (pn - 40) * 256 + cloc) = pack8(v0, v1);
                    } else if (pn < 64) {
                        const bool isk = pn < 56;
                        const int c = (pn - (isk ? 48 : 56)) * 256 + cloc;
                        bf16_t* d; float* o = nullptr;
                        if (row < MP) { d = (isk ? KP : VP) + (size_t)row * DM + c; if (row >= MP - 512) o = out + (isk ? O_KP : O_VP) + (size_t)(row - (MP - 512)) * DM + c; }
                        else { const int t = (row - MP) & 63, b = (row - MP) >> 6; d = (isk ? KS : VS) + ((size_t)b * 576 + 512 + t) * DM + c; o = out + (isk ? O_KS : O_VS) + (size_t)(row - MP) * DM + c; }
                        *(u32x4*)d = pack8(v0, v1);
                        if (o) { *(f32x4*)o = v0; *(f32x4*)(o + 4) = v1; }
                    } else if (pn < 80) {
#pragma unroll
                        for (int j = 0; j < 4; ++j) { v0[j] = fsig(v0[j]); v1[j] = fsig(v1[j]); }
                        *(u32x4*)(GT + (size_t)row * 4096 + (pn - 64) * 256 + cloc) = pack8(v0, v1);
                    } else {
                        if (cloc < 64) {
                            const f32x4 b0 = *(const f32x4*)(dt_bias + cloc), b1 = *(const f32x4*)(dt_bias + cloc + 4);
#pragma unroll
                            for (int j = 0; j < 4; ++j) { float a = v0[j] + b0[j]; v0[j] = a > 20.f ? a : log1pf(__expf(a)); float c2 = v1[j] + b1[j]; v1[j] = c2 > 20.f ? c2 : log1pf(__expf(c2)); }
                            *(f32x4*)(DT + (size_t)row * 64 + cloc) = v0; *(f32x4*)(DT + (size_t)row * 64 + cloc + 4) = v1;
                        }
                    }
                }
            }
    }
};

struct EpiSsdOut {
    static constexpr bool PERM = false;
    float* part; const bf16_t* GT;
    __device__ __forceinline__ void operator()(const f32x4 (&acc)[2][2][4][2], const Unit& u, int wr, int wc, int fr, int fq) const {
        const int rbase = u.pm * 256 + wr * 64 + fr, cbase = u.pn * 256 + wc * 32 + 4 * fq;
#pragma unroll
        for (int ai = 0; ai < 2; ++ai)
#pragma unroll
            for (int m = 0; m < 4; ++m) {
                const int row = rbase + ai * 128 + m * 16;
#pragma unroll
                for (int bj = 0; bj < 2; ++bj)
#pragma unroll
                    for (int n = 0; n < 2; ++n) {
                        const int col = cbase + bj * 128 + n * 16;
                        const u32x2 g = *(const u32x2*)(GT + (size_t)row * 4096 + col);
                        f32x4 v = acc[ai][bj][m][n];
                        v[0] *= lo2f(g.x); v[1] *= hi2f(g.x); v[2] *= lo2f(g.y); v[3] *= hi2f(g.y);
                        *(f32x4*)(part + (size_t)row * DM + col) = v;
                    }
            }
    }
};
struct EpiAttOut {
    static constexpr bool PERM = false;
    const float* part; const bf16_t* GT; bf16_t* MIXED;
    __device__ __forceinline__ void operator()(const f32x4 (&acc)[2][2][4][2], const Unit& u, int wr, int wc, int fr, int fq) const {
        const int rbase = u.pm * 256 + wr * 64 + fr, cbase = u.pn * 256 + wc * 32 + 4 * fq;
#pragma unroll
        for (int ai = 0; ai < 2; ++ai)
#pragma unroll
            for (int m = 0; m < 4; ++m) {
                const int row = rbase + ai * 128 + m * 16;
#pragma unroll
                for (int bj = 0; bj < 2; ++bj)
#pragma unroll
                    for (int n = 0; n < 2; ++n) {
                        const int col = cbase + bj * 128 + n * 16;
                        const u32x2 g = *(const u32x2*)(GT + (size_t)row * 4096 + 2048 + col);
                        const f32x4 pv = *(const f32x4*)(part + (size_t)row * DM + col);
                        f32x4 v = acc[ai][bj][m][n];
                        v[0] = pv[0] + v[0] * lo2f(g.x); v[1] = pv[1] + v[1] * hi2f(g.x); v[2] = pv[2] + v[2] * lo2f(g.y); v[3] = pv[3] + v[3] * hi2f(g.y);
                        u32x2 w; w.x = pk2(v[0], v[1]); w.y = pk2(v[2], v[3]);
                        *(u32x2*)(MIXED + (size_t)row * DM + col) = w;
                    }
            }
    }
};
struct EpiResid {
    static constexpr bool PERM = false;
    const float* resP; const float* resS; float* dst;
    __device__ __forceinline__ void operator()(const f32x4 (&acc)[2][2][4][2], const Unit& u, int wr, int wc, int fr, int fq) const {
        const int rbase = u.pm * 256 + wr * 64 + fr, cbase = u.pn * 256 + wc * 32 + 4 * fq;
#pragma unroll
        for (int ai = 0; ai < 2; ++ai)
#pragma unroll
            for (int m = 0; m < 4; ++m) {
                const int row = rbase + ai * 128 + m * 16;
                const float* rp = row < MP ? resP + (size_t)row * DM : resS + (size_t)(row - MP) * DM;
#pragma unroll
                for (int bj = 0; bj < 2; ++bj)
#pragma unroll
                    for (int n = 0; n < 2; ++n) {
                        const int col = cbase + bj * 128 + n * 16;
                        const f32x4 r = *(const f32x4*)(rp + col);
                        *(f32x4*)(dst + (size_t)row * DM + col) = acc[ai][bj][m][n] + r * ALPHA;
                    }
            }
    }
};
struct EpiGateUp {
    static constexpr bool PERM = false;
    bf16_t* ACT;
    __device__ __forceinline__ void operator()(const f32x4 (&acc)[2][2][4][2], const Unit& u, int wr, int wc, int fr, int fq) const {
        const int rbase = u.pm * 256 + wr * 64 + fr, cbase = u.pn * 128 + wc * 16 + 4 * fq;
#pragma unroll
        for (int ai = 0; ai < 2; ++ai)
#pragma unroll
            for (int m = 0; m < 4; ++m) {
                const int row = rbase + ai * 128 + m * 16;
#pragma unroll
                for (int bj = 0; bj < 2; ++bj) {
                    const f32x4 gt = acc[ai][bj][m][0], up = acc[ai][bj][m][1];
                    u32x2 w; w.x = pk2(fsilu(gt[0]) * up[0], fsilu(gt[1]) * up[1]); w.y = pk2(fsilu(gt[2]) * up[2], fsilu(gt[3]) * up[3]);
                    *(u32x2*)(ACT + (size_t)row * DFF + cbase + bj * 64) = w;
                }
            }
    }
};

template <int MAP> __device__ __forceinline__ int srccol(int n) {
    if (MAP == 0) return n;
    if (MAP == 1) { if (n < 10240) return n; if (n < 20480) return n + 64; if (n < 20544) return n - 20480 + 10240; return -1; }
    const int pn = n >> 8, c = n & 255;
    return ((c & 16) ? DFF : 0) + 128 * pn + 64 * (c >> 7) + 16 * ((c >> 5) & 3) + (c & 15);
}
template <int MAP> __device__ __forceinline__ void tr_cvt(const float* __restrict__ src, int ldsrc, int K, bf16_t* __restrict__ dst, int Nd) {
    float* T = (float*)g_lds;
    const int tid = threadIdx.x, tx = tid & 63, ty = tid >> 6, kx2 = (tid & 31) * 2, ny = tid >> 5;
    const int ntn = Nd / 64, ntiles = ntn * (K / 64);
    for (int tile = blockIdx.x; tile < ntiles; tile += gridDim.x) {
        const int n0 = (tile % ntn) * 64, k0 = (tile / ntn) * 64;
        const int sc = srccol<MAP>(n0 + tx);
#pragma unroll
        for (int kk = ty; kk < 64; kk += 8) T[kk * 65 + tx] = sc >= 0 ? src[(size_t)(k0 + kk) * ldsrc + sc] : 0.f;
        __syncthreads();
#pragma unroll
        for (int nn = ny; nn < 64; nn += 16) *(unsigned*)(dst + (size_t)(n0 + nn) * K + k0 + kx2) = pk2(T[kx2 * 65 + nn], T[(kx2 + 1) * 65 + nn]);
        __syncthreads();
    }
}

__device__ __forceinline__ void phase0(const Params& p) {
    const size_t gt = (size_t)blockIdx.x * 512 + threadIdx.x, gs = (size_t)gridDim.x * 512;
    bf16_t* XB = (bf16_t*)(p.ws + OFF_XB);
    for (size_t i = gt; i < (size_t)MT * 256; i += gs) {
        const size_t row = i >> 8; const int c8 = (int)(i & 255) * 8;
        const float* s = row < MP ? p.in[0] + row * DM + c8 : p.in[1] + (row - MP) * DM + c8;
        *(u32x4*)(XB + row * DM + c8) = cvt8(s);
    }
    bf16_t* KS = (bf16_t*)(p.ws + OFF_KSB); bf16_t* VS = (bf16_t*)(p.ws + OFF_VSB);
    for (size_t i = gt; i < (size_t)16 * 512 * 256; i += gs) {
        const size_t b = i / (512 * 256), rem = i % (512 * 256), j = rem >> 8; const int c8 = (int)(rem & 255) * 8;
        const size_t so = (b * 512 + j) * DM + c8, dof = (b * 576 + j) * DM + c8;
        *(u32x4*)(KS + dof) = cvt8(p.in[2] + so); *(u32x4*)(VS + dof) = cvt8(p.in[3] + so);
    }
    tr_cvt<1>(p.in[6], NIN_SRC, DM, (bf16_t*)(p.ws + OFF_WIN), NIN);
    tr_cvt<0>(p.in[14], DM, SI, (bf16_t*)(p.ws + OFF_WSSD), DM);
    tr_cvt<0>(p.in[15], DM, DM, (bf16_t*)(p.ws + OFF_WATT), DM);
    tr_cvt<0>(p.in[16], DM, DM, (bf16_t*)(p.ws + OFF_WO), DM);
}

__device__ __forceinline__ void unpack8(const u32x4 v, float (&f)[8]) { f[0] = lo2f(v.x); f[1] = hi2f(v.x); f[2] = lo2f(v.y); f[3] = hi2f(v.y); f[4] = lo2f(v.z); f[5] = hi2f(v.z); f[6] = lo2f(v.w); f[7] = hi2f(v.w); }
__device__ __forceinline__ void load8f(const float* s, float (&f)[8]) { const f32x4 a = *(const f32x4*)s, b = *(const f32x4*)(s + 4); f[0] = a[0]; f[1] = a[1]; f[2] = a[2]; f[3] = a[3]; f[4] = b[0]; f[5] = b[1]; f[6] = b[2]; f[7] = b[3]; }
__device__ __forceinline__ void conv_phase(const Params& p) {
    const size_t gt = (size_t)blockIdx.x * 512 + threadIdx.x, gs = (size_t)gridDim.x * 512;
    const bf16_t* XBC = (const bf16_t*)(p.ws + OFF_XBC); bf16_t* XC = (bf16_t*)(p.ws + OFF_XC);
    const float* cw = p.in[7]; const float* cb = p.in[8]; const float* sc = p.in[4];
    for (size_t it = gt; it < (size_t)576 * 768; it += gs) {
        const int cgi = (int)(it % 768), rb = (int)(it / 768), c = cgi * 8, r0 = rb * 16;
        float w0[8], w1[8], w2[8], w3[8], bb[8], h0[8], h1[8], h2[8];
        load8f(cw + c, w0); load8f(cw + CD + c, w1); load8f(cw + 2 * CD + c, w2); load8f(cw + 3 * CD + c, w3); load8f(cb + c, bb);
        const bool sstart = (r0 >= MP) && (((r0 - MP) & 63) == 0);
        if (r0 == 0) {
#pragma unroll
            for (int k = 0; k < 8; ++k) { h0[k] = 0.f; h1[k] = 0.f; h2[k] = 0.f; }
        } else if (sstart) {
            const int b = (r0 - MP) >> 6;
            load8f(sc + (size_t)(b * 3 + 0) * CD + c, h0); load8f(sc + (size_t)(b * 3 + 1) * CD + c, h1); load8f(sc + (size_t)(b * 3 + 2) * CD + c, h2);
        } else {
            unpack8(*(const u32x4*)(XBC + (size_t)(r0 - 3) * CD + c), h0); unpack8(*(const u32x4*)(XBC + (size_t)(r0 - 2) * CD + c), h1); unpack8(*(const u32x4*)(XBC + (size_t)(r0 - 1) * CD + c), h2);
        }
#pragma unroll 4
        for (int rr = 0; rr < 16; ++rr) {
            float cur[8], o[8];
            unpack8(*(const u32x4*)(XBC + (size_t)(r0 + rr) * CD + c), cur);
#pragma unroll
            for (int k = 0; k < 8; ++k) { o[k] = fsilu(bb[k] + h0[k] * w0[k] + h1[k] * w1[k] + h2[k] * w2[k] + cur[k] * w3[k]); h0[k] = h1[k]; h1[k] = h2[k]; h2[k] = cur[k]; }
            u32x4 w; w.x = pk2(o[0], o[1]); w.y = pk2(o[2], o[3]); w.z = pk2(o[4], o[5]); w.w = pk2(o[6], o[7]);
            *(u32x4*)(XC + (size_t)(r0 + rr) * CD + c) = w;
        }
    }
}

__device__ __forceinline__ void ssd_phase(const Params& p) {
    const int tid = threadIdx.x, lane = tid & 63, w = tid >> 6, l15 = lane & 15, lq = lane >> 4;
    bf16_t* Bn = (bf16_t*)(g_lds);
    bf16_t* Cn = (bf16_t*)(g_lds + 17408);
    bf16_t* Xt = (bf16_t*)(g_lds + 34816);
    bf16_t* Xw = (bf16_t*)(g_lds + 37120);
    bf16_t* Mm = (bf16_t*)(g_lds + 39424);
    bf16_t* Hh = (bf16_t*)(g_lds + 48640);
    float* fcs = (float*)(g_lds + 52992);
    float* fdt = fcs + 64; float* fwj = fcs + 128; float* fec = fcs + 192; float* fms = fcs + 256;
    const bf16_t* XC = (const bf16_t*)(p.ws + OFF_XC); const float* DT = (const float*)(p.ws + OFF_DT);
    bf16_t* Y = (bf16_t*)(p.ws + OFF_Y);
    for (int item = blockIdx.x; item < 256; item += gridDim.x) {
        const int head = item >> 2, pq = item & 3, g = head >> 3;
        const float a_h = -__expf(p.in[10][head]), dskip = p.in[11][head];
        u32x4 rb[2], rc[2], rx; float rdt = 0.f;
        f32x4 hacc[2]; hacc[0] = (f32x4){0.f, 0.f, 0.f, 0.f}; hacc[1] = hacc[0];
        __syncthreads();
        if (w >= 4) {
#pragma unroll
            for (int tt = 0; tt < 2; ++tt)
#pragma unroll
                for (int e = 0; e < 4; ++e) Hh[(lq * 4 + e) * 136 + ((w - 4) * 2 + tt) * 16 + l15] = 0;
        }
#define SSD_LOAD(s_) do { const size_t R0_ = (size_t)(s_) * 64; \
            _Pragma("unroll") for (int e = 0; e < 2; ++e) { const int v = tid + 512 * e, j = v >> 4, n8 = (v & 15) * 8; \
                rb[e] = *(const u32x4*)(XC + (R0_ + j) * CD + 4096 + g * 128 + n8); rc[e] = *(const u32x4*)(XC + (R0_ + j) * CD + 5120 + g * 128 + n8); } \
            if (tid < 128) rx = *(const u32x4*)(XC + (R0_ + (tid >> 1)) * CD + head * 64 + pq * 16 + (tid & 1) * 8); \
            if (tid < 64) rdt = DT[(R0_ + tid) * 64 + head]; } while (0)
        SSD_LOAD(0);
        for (int s = 0; s < 144; ++s) {
            const size_t R0 = (size_t)s * 64;
#pragma unroll
            for (int e = 0; e < 2; ++e) { const int v = tid + 512 * e, j = v >> 4, n8 = (v & 15) * 8;
                *(u32x4*)(Bn + j * 136 + n8) = rb[e]; *(u32x4*)(Cn + j * 136 + n8) = rc[e]; }
            if (tid < 128) { const int j = tid >> 1, p8 = (tid & 1) * 8;
                Xt[(p8 + 0) * 72 + j] = (bf16_t)(rx.x & 0xffff); Xt[(p8 + 1) * 72 + j] = (bf16_t)(rx.x >> 16);
                Xt[(p8 + 2) * 72 + j] = (bf16_t)(rx.y & 0xffff); Xt[(p8 + 3) * 72 + j] = (bf16_t)(rx.y >> 16);
                Xt[(p8 + 4) * 72 + j] = (bf16_t)(rx.z & 0xffff); Xt[(p8 + 5) * 72 + j] = (bf16_t)(rx.z >> 16);
                Xt[(p8 + 6) * 72 + j] = (bf16_t)(rx.w & 0xffff); Xt[(p8 + 7) * 72 + j] = (bf16_t)(rx.w >> 16); }
            if (w == 0) {
                float x = rdt * a_h;
#pragma unroll
                for (int off = 1; off < 64; off <<= 1) { const float y = __shfl_up(x, off, 64); if (lane >= off) x += y; }
                const float last = __shfl(x, 63, 64);
                fcs[lane] = x; fdt[lane] = rdt; fwj[lane] = __expf(last - x) * rdt; fec[lane] = __expf(x);
                if (lane == 63) fms[0] = __expf(x);
            }
            __syncthreads();
            if (s + 1 < 144) SSD_LOAD(s + 1);
            {
                const int it = w >> 1;
#pragma unroll
                for (int tj = 0; tj < 2; ++tj) {
                    const int jt = (w & 1) * 2 + tj;
                    f32x4 acc = (f32x4){0.f, 0.f, 0.f, 0.f};
#pragma unroll
                    for (int nk = 0; nk < 4; ++nk) {
                        const bf16x8 A = *(const bf16x8*)(Cn + (it * 16 + l15) * 136 + nk * 32 + lq * 8);
                        const bf16x8 B = *(const bf16x8*)(Bn + (jt * 16 + l15) * 136 + nk * 32 + lq * 8);
                        acc = mfma16(A, B, acc);
                    }
                    const int j = jt * 16 + l15; const float csj = fcs[j], dtj = fdt[j];
#pragma unroll
                    for (int e = 0; e < 4; ++e) { const int i = it * 16 + lq * 4 + e;
                        const float v = (j <= i) ? acc[e] * __expf(fcs[i] - csj) * dtj : 0.f;
                        Mm[i * 72 + j] = f2bf(v); }
                }
#pragma unroll
                for (int e = 0; e < 2; ++e) { const int idx = tid + 512 * e, pp = idx >> 6, j = idx & 63; Xw[pp * 72 + j] = f2bf(bf2f(Xt[pp * 72 + j]) * fwj[j]); }
            }
            __syncthreads();
            if (w < 4) {
                const int it = w;
                f32x4 accd = (f32x4){0.f, 0.f, 0.f, 0.f}, acco = accd;
#pragma unroll
                for (int jk = 0; jk < 2; ++jk) {
                    const bf16x8 A = *(const bf16x8*)(Mm + (it * 16 + l15) * 72 + jk * 32 + lq * 8);
                    const bf16x8 B = *(const bf16x8*)(Xt + l15 * 72 + jk * 32 + lq * 8);
                    accd = mfma16(A, B, accd);
                }
#pragma unroll
                for (int nk = 0; nk < 4; ++nk) {
                    const bf16x8 A = *(const bf16x8*)(Cn + (it * 16 + l15) * 136 + nk * 32 + lq * 8);
                    const bf16x8 B = *(const bf16x8*)(Hh + l15 * 136 + nk * 32 + lq * 8);
                    acco = mfma16(A, B, acco);
                }
#pragma unroll
                for (int e = 0; e < 4; ++e) { const int i = it * 16 + lq * 4 + e;
                    const float yv = accd[e] + fec[i] * acco[e] + dskip * bf2f(Xt[l15 * 72 + i]);
                    Y[(R0 + i) * SI + head * 64 + pq * 16 + l15] = f2bf(yv); }
            } else {
                const float cdec = fms[0];
#pragma unroll
                for (int tt = 0; tt < 2; ++tt) {
                    const int nt = (w - 4) * 2 + tt;
                    hacc[tt] *= cdec;
#pragma unroll
                    for (int jk = 0; jk < 2; ++jk) {
                        const bf16x8 A = *(const bf16x8*)(Xw + l15 * 72 + jk * 32 + lq * 8);
                        bf16x8 B;
#pragma unroll
                        for (int e = 0; e < 8; ++e) B[e] = (short)Bn[(jk * 32 + lq * 8 + e) * 136 + nt * 16 + l15];
                        hacc[tt] = mfma16(A, B, hacc[tt]);
                    }
                }
            }
            __syncthreads();
            if (w >= 4) {
                if (s >= 127) {
                    float* dst = (s == 127) ? p.out + O_SSMP + ((size_t)head * 64 + pq * 16) * 128
                                            : p.out + O_SSMS + (((size_t)(s - 128) * 64 + head) * 64 + pq * 16) * 128;
#pragma unroll
                    for (int tt = 0; tt < 2; ++tt)
#pragma unroll
                        for (int e = 0; e < 4; ++e) dst[(lq * 4 + e) * 128 + ((w - 4) * 2 + tt) * 16 + l15] = hacc[tt][e];
                    if (s + 1 < 144) {
                        const float* src = p.in[5] + (((size_t)(s + 1 - 128) * 64 + head) * 64 + pq * 16) * 128;
#pragma unroll
                        for (int tt = 0; tt < 2; ++tt)
#pragma unroll
                            for (int e = 0; e < 4; ++e) hacc[tt][e] = src[(lq * 4 + e) * 128 + ((w - 4) * 2 + tt) * 16 + l15];
                    }
                }
#pragma unroll
                for (int tt = 0; tt < 2; ++tt)
#pragma unroll
                    for (int e = 0; e < 4; ++e) Hh[(lq * 4 + e) * 136 + ((w - 4) * 2 + tt) * 16 + l15] = f2bf(hacc[tt][e]);
            }
        }
#undef SSD_LOAD
    }
}

__device__ __forceinline__ int vt_addr(int d, int key) { return d * 64 + ((((key >> 2) ^ (d ^ (d >> 3))) & 15) << 2) + (key & 3); }
__device__ __forceinline__ void attn_phase(const Params& p) {
    const int tid = threadIdx.x, hw = tid >> 8, ht = tid & 255, lane = tid & 63, wq = (tid >> 6) & 3, l15 = lane & 15, lq = lane >> 4;
    unsigned char* hb = g_lds + hw * 36992;
    bf16_t* Ks = (bf16_t*)hb;
    bf16_t* Vt = (bf16_t*)(hb + 17408);
    float* bs = (float*)(hb + 33792);
    const bf16_t* Qg = (const bf16_t*)(p.ws + OFF_Q);
    bf16_t* ATT = (bf16_t*)(p.ws + OFF_ATT);
    const float scale = 0.08838834764831845f;
    for (int pi = blockIdx.x; pi < 1152; pi += gridDim.x) {
        const int u = pi * 2 + hw, head = u & 15;
        int qrow0, krow0; const bf16_t* Kg; const bf16_t* Vg;
        if (u < 2048) { const int n = u >> 4; qrow0 = n * 64; krow0 = n * 64 - 512; Kg = (const bf16_t*)(p.ws + OFF_KPB); Vg = (const bf16_t*)(p.ws + OFF_VPB); }
        else { const int b = (u - 2048) >> 4; qrow0 = MP + b * 64; krow0 = 0; Kg = (const bf16_t*)(p.ws + OFF_KSB) + (size_t)b * 576 * DM; Vg = (const bf16_t*)(p.ws + OFF_VSB) + (size_t)b * 576 * DM; }
        __syncthreads();
        for (int i = ht; i < 257; i += 256) bs[i] = p.in[13][head * 257 + i];
        bf16x8 Qf[4];
        { const bf16_t* qp = Qg + (size_t)(qrow0 + wq * 16 + l15) * DM + head * 128 + lq * 8;
#pragma unroll
          for (int ks = 0; ks < 4; ++ks) Qf[ks] = *(const bf16x8*)(qp + ks * 32); }
        float mrun = -INFINITY, lrun = 0.f;
        f32x4 o[8];
#pragma unroll
        for (int db = 0; db < 8; ++db) o[db] = (f32x4){0.f, 0.f, 0.f, 0.f};
        u32x4 rk[4], rv[4];
#define ATT_LOAD(t_) do { const int kr_ = krow0 + (t_) * 64; if (kr_ >= 0) { \
            _Pragma("unroll") for (int e = 0; e < 4; ++e) { const int v = ht + 256 * e; rk[e] = *(const u32x4*)(Kg + (size_t)(kr_ + (v >> 4)) * DM + head * 128 + (v & 15) * 8); } \
            _Pragma("unroll") for (int e2 = 0; e2 < 2; ++e2) { const int kp = (ht >> 4) + 16 * e2; \
                rv[e2 * 2] = *(const u32x4*)(Vg + (size_t)(kr_ + 2 * kp) * DM + head * 128 + (ht & 15) * 8); rv[e2 * 2 + 1] = *(const u32x4*)(Vg + (size_t)(kr_ + 2 * kp + 1) * DM + head * 128 + (ht & 15) * 8); } } } while (0)
        ATT_LOAD(8);
        for (int itl = 0; itl < 9; ++itl) {
            const int t = itl == 0 ? 8 : itl - 1;
            const bool valid = (krow0 + t * 64) >= 0;
            __syncthreads();
            if (valid) {
#pragma unroll
                for (int e = 0; e < 4; ++e) { const int v = ht + 256 * e; *(u32x4*)(Ks + (v >> 4) * 136 + (v & 15) * 8) = rk[e]; }
#pragma unroll
                for (int e2 = 0; e2 < 2; ++e2) { const int kp = (ht >> 4) + 16 * e2, d0 = (ht & 15) * 8; const u32x4 a = rv[e2 * 2], b = rv[e2 * 2 + 1];
                    *(unsigned*)(Vt + vt_addr(d0 + 0, 2 * kp)) = (a.x & 0xffffu) | (b.x << 16); *(unsigned*)(Vt + vt_addr(d0 + 1, 2 * kp)) = (a.x >> 16) | (b.x & 0xffff0000u);
                    *(unsigned*)(Vt + vt_addr(d0 + 2, 2 * kp)) = (a.y & 0xffffu) | (b.y << 16); *(unsigned*)(Vt + vt_addr(d0 + 3, 2 * kp)) = (a.y >> 16) | (b.y & 0xffff0000u);
                    *(unsigned*)(Vt + vt_addr(d0 + 4, 2 * kp)) = (a.z & 0xffffu) | (b.z << 16); *(unsigned*)(Vt + vt_addr(d0 + 5, 2 * kp)) = (a.z >> 16) | (b.z & 0xffff0000u);
                    *(unsigned*)(Vt + vt_addr(d0 + 6, 2 * kp)) = (a.w & 0xffffu) | (b.w << 16); *(unsigned*)(Vt + vt_addr(d0 + 7, 2 * kp)) = (a.w >> 16) | (b.w & 0xffff0000u); }
            }
            __syncthreads();
            if (itl + 1 < 9) ATT_LOAD(itl);
            if (valid) {
                f32x4 sc[4];
#pragma unroll
                for (int kt = 0; kt < 4; ++kt) { sc[kt] = (f32x4){0.f, 0.f, 0.f, 0.f};
#pragma unroll
                    for (int ks = 0; ks < 4; ++ks) { const bf16x8 A = *(const bf16x8*)(Ks + (kt * 16 + l15) * 136 + ks * 32 + lq * 8); sc[kt] = mfma16(A, Qf[ks], sc[kt]); } }
                const int qi = wq * 16 + l15;
                float tmax = -INFINITY;
#pragma unroll
                for (int kt = 0; kt < 4; ++kt)
#pragma unroll
                    for (int e = 0; e < 4; ++e) { const int j = t * 64 + kt * 16 + lq * 4 + e; int rel = qi - j + 512; rel = rel < -128 ? -128 : (rel > 128 ? 128 : rel);
                        const float sv = sc[kt][e] * scale + bs[rel + 128]; sc[kt][e] = sv; tmax = fmaxf(tmax, sv); }
                tmax = fmaxf(tmax, __shfl_xor(tmax, 16, 64)); tmax = fmaxf(tmax, __shfl_xor(tmax, 32, 64));
                const float mnew = fmaxf(mrun, tmax), alpha = __expf(mrun - mnew);
                float psum = 0.f;
#pragma unroll
                for (int kt = 0; kt < 4; ++kt)
#pragma unroll
                    for (int e = 0; e < 4; ++e) { const float pv = __expf(sc[kt][e] - mnew); sc[kt][e] = pv; psum += pv; }
                psum += __shfl_xor(psum, 16, 64); psum += __shfl_xor(psum, 32, 64);
                lrun = lrun * alpha + psum; mrun = mnew;
#pragma unroll
                for (int db = 0; db < 8; ++db) o[db] *= alpha;
                bf16x8 Bp[2];
#pragma unroll
                for (int k2 = 0; k2 < 2; ++k2) { u32x4 w; w.x = pk2(sc[2 * k2][0], sc[2 * k2][1]); w.y = pk2(sc[2 * k2][2], sc[2 * k2][3]); w.z = pk2(sc[2 * k2 + 1][0], sc[2 * k2 + 1][1]); w.w = pk2(sc[2 * k2 + 1][2], sc[2 * k2 + 1][3]);
                    Bp[k2] = __builtin_bit_cast(bf16x8, w); }
#pragma unroll
                for (int db = 0; db < 8; ++db)
#pragma unroll
                    for (int k2 = 0; k2 < 2; ++k2) { const int d = db * 16 + l15;
                        const u32x2 lo = *(const u32x2*)(Vt + vt_addr(d, (2 * k2) * 16 + lq * 4)), hi = *(const u32x2*)(Vt + vt_addr(d, (2 * k2 + 1) * 16 + lq * 4));
                        u32x4 w; w.x = lo.x; w.y = lo.y; w.z = hi.x; w.w = hi.y;
                        o[db] = mfma16(__builtin_bit_cast(bf16x8, w), Bp[k2], o[db]); }
            }
        }
#undef ATT_LOAD
        const float inv = 1.0f / lrun;
        bf16_t* op = ATT + (size_t)(qrow0 + wq * 16 + l15) * DM + head * 128 + lq * 4;
#pragma unroll
        for (int db = 0; db < 8; ++db) { u32x2 w; w.x = pk2(o[db][0] * inv, o[db][1] * inv); w.y = pk2(o[db][2] * inv, o[db][3] * inv); *(u32x2*)(op + db * 16) = w; }
    }
}

__device__ __forceinline__ void norm_phase(const Params& p) {
    const int lane = threadIdx.x & 63, gw = blockIdx.x * 8 + (threadIdx.x >> 6), nw = gridDim.x * 8;
    bf16_t* Y = (bf16_t*)(p.ws + OFF_Y); const bf16_t* Z = (const bf16_t*)(p.ws + OFF_Z); const float* nwt = p.in[12];
    for (int item = gw; item < MT * 8; item += nw) {
        const int row = item >> 3, g = item & 7; const size_t base = (size_t)row * SI + g * 512 + lane * 8;
        float y[8], z[8], wv[8];
        unpack8(*(const u32x4*)(Y + base), y); unpack8(*(const u32x4*)(Z + base), z); load8f(nwt + g * 512 + lane * 8, wv);
        float ss = 0.f;
#pragma unroll
        for (int k = 0; k < 8; ++k) { y[k] = y[k] * fsilu(z[k]); ss += y[k] * y[k]; }
#pragma unroll
        for (int off = 1; off < 64; off <<= 1) ss += __shfl_xor(ss, off, 64);
        const float rs = rsqrtf(ss * (1.0f / 512.0f) + 1e-5f);
        u32x4 w; w.x = pk2(y[0] * rs * wv[0], y[1] * rs * wv[1]); w.y = pk2(y[2] * rs * wv[2], y[3] * rs * wv[3]); w.z = pk2(y[4] * rs * wv[4], y[5] * rs * wv[5]); w.w = pk2(y[6] * rs * wv[6], y[7] * rs * wv[7]);
        *(u32x4*)(Y + base) = w;
    }
}

__device__ __forceinline__ void ln_phase(const float* src, const float* gam, const float* bet, float* dstf, bf16_t* dstb) {
    const int lane = threadIdx.x & 63, gw = blockIdx.x * 8 + (threadIdx.x >> 6), nw = gridDim.x * 8;
    for (int row = gw; row < MT; row += nw) {
        const float* s = src + (size_t)row * DM;
        f32x4 v[8]; float sum = 0.f;
#pragma unroll
        for (int k = 0; k < 8; ++k) { v[k] = *(const f32x4*)(s + (k * 64 + lane) * 4); sum += (v[k][0] + v[k][1]) + (v[k][2] + v[k][3]); }
#pragma unroll
        for (int off = 1; off < 64; off <<= 1) sum += __shfl_xor(sum, off, 64);
        const float mean = sum * (1.0f / 2048.0f);
        float q = 0.f;
#pragma unroll
        for (int k = 0; k < 8; ++k) { v[k] -= mean; q += (v[k][0] * v[k][0] + v[k][1] * v[k][1]) + (v[k][2] * v[k][2] + v[k][3] * v[k][3]); }
#pragma unroll
        for (int off = 1; off < 64; off <<= 1) q += __shfl_xor(q, off, 64);
        const float rs = rsqrtf(q * (1.0f / 2048.0f) + 1e-5f);
#pragma unroll
        for (int k = 0; k < 8; ++k) { const int c = (k * 64 + lane) * 4;
            const f32x4 o = v[k] * rs * *(const f32x4*)(gam + c) + *(const f32x4*)(bet + c);
            *(f32x4*)(dstf + (size_t)row * DM + c) = o;
            if (dstb) { u32x2 w; w.x = pk2(o[0], o[1]); w.y = pk2(o[2], o[3]); *(u32x2*)(dstb + (size_t)row * DM + c) = w; } }
    }
}

__global__ void __launch_bounds__(512, 2) mega(Params p) {
    const int lo = p.ph_lo, hi = p.ph_hi;
    PG8_LAS unsigned char* lds = (PG8_LAS unsigned char*)g_lds;
    const int G = gridDim.x, c = blockIdx.x;
    unsigned char* ws = p.ws;
#define IN(k) (lo <= (k) && (k) < hi)
#define SEAM(k) do { if (IN((k) + 1)) cg::this_grid().sync(); } while (0)
    if (IN(0)) { phase0(p); SEAM(0); }
    if (IN(1)) {
        pg8::Gemm g{(const bf16_t*)(ws + OFF_XB), (const bf16_t*)(ws + OFF_WIN), MT, NIN, DM}; pg8::StaticOrder S; S.init(MT, NIN, G, c);
        EpiIn E{(bf16_t*)(ws + OFF_Z), (bf16_t*)(ws + OFF_XBC), (bf16_t*)(ws + OFF_Q), (bf16_t*)(ws + OFF_KPB), (bf16_t*)(ws + OFF_VPB), (bf16_t*)(ws + OFF_KSB), (bf16_t*)(ws + OFF_VSB),
                (bf16_t*)(ws + OFF_GT), (float*)(ws + OFF_DT), p.out, p.in[9]};
        pg8::gemm_phase<EpiIn, pg8::StaticOrder>(lds, g, S, E);
        SEAM(1);
    }
    if (IN(2)) { conv_phase(p); SEAM(2); }
    if (IN(3)) { ssd_phase(p); attn_phase(p); SEAM(3); }
    if (IN(4)) {
        norm_phase(p);
        __syncthreads();
        tr_cvt<2>(p.in[19], 2 * DFF, DM, (bf16_t*)(ws + OFF_WGU), 2 * DFF);
        tr_cvt<0>(p.in[20], DM, DFF, (bf16_t*)(ws + OFF_WDN), DM);
        SEAM(4);
    }
    if (IN(5)) {
        { pg8::Gemm g{(const bf16_t*)(ws + OFF_Y), (const bf16_t*)(ws + OFF_WSSD), MT, DM, SI}; pg8::StaticOrder S; S.init(MT, DM, G, c);
          EpiSsdOut E{p.out + O_YP, (const bf16_t*)(ws + OFF_GT)};
          pg8::gemm_phase<EpiSsdOut, pg8::StaticOrder>(lds, g, S, E); }
        { pg8::Gemm g{(const bf16_t*)(ws + OFF_ATT), (const bf16_t*)(ws + OFF_WATT), MT, DM, DM}; pg8::StaticOrder S; S.init(MT, DM, G, c);
          EpiAttOut E{p.out + O_YP, (const bf16_t*)(ws + OFF_GT), (bf16_t*)(ws + OFF_MIXED)};
          pg8::gemm_phase<EpiAttOut, pg8::StaticOrder>(lds, g, S, E); }
        SEAM(5);
    }
    if (IN(6)) {
        pg8::Gemm g{(const bf16_t*)(ws + OFF_MIXED), (const bf16_t*)(ws + OFF_WO), MT, DM, DM}; pg8::StaticOrder S; S.init(MT, DM, G, c);
        EpiResid E{p.in[0], p.in[1], p.out + O_YP};
        pg8::gemm_phase<EpiResid, pg8::StaticOrder>(lds, g, S, E);
        SEAM(6);
    }
    if (IN(7)) { ln_phase(p.out + O_YP, p.in[17], p.in[18], (float*)(ws + OFF_H), (bf16_t*)(ws + OFF_HB)); SEAM(7); }
    if (IN(8)) {
        pg8::Gemm g{(const bf16_t*)(ws + OFF_HB), (const bf16_t*)(ws + OFF_WGU), MT, 2 * DFF, DM}; pg8::StaticOrder S; S.init(MT, 2 * DFF, G, c);
        EpiGateUp E{(bf16_t*)(ws + OFF_ACT)};
        pg8::gemm_phase<EpiGateUp, pg8::StaticOrder>(lds, g, S, E);
        SEAM(8);
    }
    if (IN(9)) {
        pg8::Gemm g{(const bf16_t*)(ws + OFF_ACT), (const bf16_t*)(ws + OFF_WDN), MT, DM, DFF}; pg8::StaticOrder S; S.init(MT, DM, G, c);
        EpiResid E{(const float*)(ws + OFF_H), (const float*)(ws + OFF_H) + (size_t)MP * DM, p.out + O_YP};
        pg8::gemm_phase<EpiResid, pg8::StaticOrder>(lds, g, S, E);
        SEAM(9);
    }
    if (IN(10)) { ln_phase(p.out + O_YP, p.in[21], p.in[22], p.out + O_YP, nullptr); }
#undef IN
#undef SEAM
}

extern "C" void kernel_launch(void* const* d_in, const int* in_sizes, int n_in, void* d_out, int out_size, void* d_ws, size_t ws_size, hipStream_t stream) {
    static int grid = 0;
    if (grid == 0) {
        if (n_in != 23 || ws_size < WS_END) { fprintf(stderr, "kernel_launch: unexpected n_in %d or ws_size %zu (< %zu)\n", n_in, ws_size, (size_t)WS_END); grid = -1; return; }
        int dev = 0, cus = 0, per_cu = 0;
        hipGetDevice(&dev); hipDeviceGetAttribute(&cus, hipDeviceAttributeMultiprocessorCount, dev);
        if (hipFuncSetAttribute((const void*)mega, hipFuncAttributeMaxDynamicSharedMemorySize, LDS_BYTES) != hipSuccess) { fprintf(stderr, "kernel_launch: hipFuncSetAttribute failed\n"); grid = -1; return; }
        if (hipOccupancyMaxActiveBlocksPerMultiprocessor(&per_cu, (const void*)mega, 512, LDS_BYTES) != hipSuccess || per_cu < 1) { fprintf(stderr, "kernel_launch: occupancy query gave %d\n", per_cu); (void)hipGetLastError(); grid = -1; return; }
        grid = cus;
    }
    if (grid < 0) return;
    Params p{};
    for (int i = 0; i < 23; ++i) p.in[i] = (const float*)d_in[i];
    p.out = (float*)d_out; p.ws = (unsigned char*)d_ws;
#if ONE_LAUNCH
    p.ph_lo = 0; p.ph_hi = NPH;
    void* args[] = {&p};
    hipError_t e = hipLaunchCooperativeKernel((const void*)mega, dim3(grid), dim3(512), args, LDS_BYTES, stream);
    if (e != hipSuccess) fprintf(stderr, "cooperative launch failed: %s (grid %d)\n", hipGetErrorString(e), grid);
#else
    for (int ph = 0; ph < NPH; ++ph) { p.ph_lo = ph; p.ph_hi = ph + 1; hipLaunchKernelGGL(mega, dim3(grid), dim3(512), LDS_BYTES, stream, p); }
#endif
}
```

```cpp
#include <hip/hip_runtime.h>
#include <hip/hip_cooperative_groups.h>
#include <cstdio>
namespace cg = cooperative_groups;

#ifndef ONE_LAUNCH
#define ONE_LAUNCH 1
#endif

typedef unsigned short bf16_t;
typedef short bf16x8 __attribute__((ext_vector_type(8)));
typedef float f32x4 __attribute__((ext_vector_type(4)));
typedef unsigned u32x4 __attribute__((ext_vector_type(4)));
typedef unsigned u32x2 __attribute__((ext_vector_type(2)));

extern __shared__ __attribute__((aligned(16))) unsigned char g_lds[];

constexpr int MP = 8192, MS = 1024, MT = 9216, DM = 2048, SI = 4096, CD = 6144, DFF = 5632;
constexpr int NIN_SRC = 20544, NIN = 20736;
constexpr float ALPHA = 1.189207115002721f;
constexpr int NPH = 11;
constexpr int LDS_BYTES = 131072;
constexpr size_t O_YP = 0, O_CONVP = 18874368, O_SSMP = 18892800, O_KP = 19417088, O_VP = 20465664,
                 O_CONVS = 21514240, O_SSMS = 21809152, O_KS = 30197760, O_VS = 32294912;
constexpr size_t OFF_XB = 0, OFF_WIN = 37748736, OFF_XC = 0, OFF_ACT = 0;
constexpr size_t OFF_XBC = 122683392, OFF_Y = OFF_XBC, OFF_ATT = OFF_XBC + 75497472;
constexpr size_t OFF_Q = 235929600, OFF_KPB = 273678336, OFF_VPB = 307232768, OFF_KSB = 340787200, OFF_VSB = 378535936;
constexpr size_t OFF_WGU = OFF_Q, OFF_WDN = 282066944, OFF_MIXED = 305135616, OFF_HB = 342884352;
constexpr size_t OFF_Z = 416284672, OFF_H = OFF_Z, OFF_GT = 491782144, OFF_DT = 567279616;
constexpr size_t OFF_WSSD = 569638912, OFF_WATT = 586416128, OFF_WO = 594804736, WS_END = 603193344;

struct Params { const float* in[23]; float* out; unsigned char* ws; int ph_lo, ph_hi; };

__device__ __forceinline__ unsigned pk2(float lo, float hi) { unsigned r; asm volatile("v_cvt_pk_bf16_f32 %0, %1, %2" : "=v"(r) : "v"(lo), "v"(hi)); return r; }
__device__ __forceinline__ bf16_t f2bf(float f) { unsigned u = __float_as_uint(f); u += 0x7FFFu + ((u >> 16) & 1u); return (bf16_t)(u >> 16); }
__device__ __forceinline__ float bf2f(bf16_t b) { return __uint_as_float(((unsigned)b) << 16); }
__device__ __forceinline__ float lo2f(unsigned w) { return __uint_as_float(w << 16); }
__device__ __forceinline__ float hi2f(unsigned w) { return __uint_as_float(w & 0xffff0000u); }
__device__ __forceinline__ float fsig(float x) { return __builtin_amdgcn_rcpf(1.0f + __expf(-x)); }
__device__ __forceinline__ float fsilu(float x) { return x * fsig(x); }
__device__ __forceinline__ u32x4 cvt8(const float* s) {
    const f32x4 a = *(const f32x4*)s, b = *(const f32x4*)(s + 4);
    u32x4 r; r.x = pk2(a[0], a[1]); r.y = pk2(a[2], a[3]); r.z = pk2(b[0], b[1]); r.w = pk2(b[2], b[3]); return r;
}
__device__ __forceinline__ f32x4 mfma16(bf16x8 a, bf16x8 b, f32x4 c) { return __builtin_amdgcn_mfma_f32_16x16x32_bf16(a, b, c, 0, 0, 0); }

namespace pg8 {
#define PG8_LAS __attribute__((address_space(3)))
constexpr int BM = 256, BK = 64, HALF = 128, HTB = HALF * BK * 2, STAGE_BYTES = 8 * HTB, NXCD = 8, WGM = 8;
__host__ __device__ __forceinline__ int lds_byte(int r, int c) { const int st = (r >> 4) * 2 + (c >> 5), rr = r & 15, cc = c & 31, ob = rr * 64 + cc * 2; return st * 1024 + (ob ^ (((ob >> 9) & 1) << 5)); }
__host__ __device__ __forceinline__ void stage_rc(int b, int& R, int& C) { const int st = b / 1024, sb = b % 1024, swz = sb ^ (((sb >> 9) & 1) << 5); R = (st >> 1) * 16 + swz / 64; C = (st & 1) * 32 + (swz % 64) / 2; }
__host__ __device__ __forceinline__ int perm32(int rho) { const int n = rho >> 4, i = rho & 15; return 8 * (i >> 2) + 4 * n + (i & 3); }
struct Unit { int pm, pn; };
struct Gemm { const bf16_t* A; const bf16_t* Bt; int M, N, K; };
struct StaticOrder {
    int nM, nN, nwg, G, c;
    __host__ __device__ void init(int M, int N, int G_, int c_) { nM = M / BM; nN = N / BM; nwg = nM * nN; G = G_; c = c_; }
    __host__ __device__ bool next(int i, Unit& u) const {
        const long L = (long)i * G + c; if (L >= nwg) return false;
        int wgid = (int)L; { const int q = nwg / NXCD, r = nwg % NXCD, xcd = wgid % NXCD, off = wgid / NXCD; wgid = (xcd < r ? xcd * (q + 1) : r * (q + 1) + (xcd - r) * q) + off; }
        const int nig = WGM * nN, gid = wgid / nig, fm = gid * WGM, gsz = (nM - fm) < WGM ? (nM - fm) : WGM;
        u.pm = fm + ((wgid % nig) % gsz); u.pn = (wgid % nig) / gsz; return true;
    }
    __device__ __forceinline__ void a_ready(const Unit&) const {}
    __device__ __forceinline__ void done(const Unit&) const {}
};

template <class Epi, class Sched>
__device__ __forceinline__ void gemm_phase(PG8_LAS unsigned char* lds, const Gemm g, const Sched& S, const Epi& E) {
    const int tid = threadIdx.x, wid = __builtin_amdgcn_readfirstlane(tid >> 6), lane = tid & 63, wr = wid >> 2, wc = wid & 3, fr = lane & 15, fq = lane >> 4;
    const int K = g.K, nt = K / BK;
    unsigned voffA[2], voffB[2];
#pragma unroll
    for (int i = 0; i < 2; ++i) { int R, C; stage_rc(tid * 16 + i * 8192, R, C); const int Rb = Epi::PERM ? ((R & ~31) + perm32(R & 31)) : R;
        voffA[i] = (unsigned)(R * K + C) * 2u; voffB[i] = (unsigned)(Rb * K + C) * 2u; }
    const size_t kstep = (size_t)(BK * 2);
    const size_t hstep = (size_t)HALF * K * 2;
    const size_t tstep = 2 * hstep;
    const unsigned ldsw = (unsigned)wid * 1024u;
    const int aoff = lds_byte(wr * 64 + fr, fq * 8), boff = lds_byte(wc * 32 + fr, fq * 8);
#define PG8_SA(b, h) (((b) * 2 + (h)) * HTB)
#define PG8_SB(b, h) ((4 + (b) * 2 + (h)) * HTB)
#define PG8_STAGE(bufoff, gbase, voff) do { _Pragma("unroll") for (int _i = 0; _i < 2; ++_i) \
        __builtin_amdgcn_global_load_lds((const unsigned*)((const char*)(gbase) + (voff)[_i]), (PG8_LAS unsigned*)(lds + (bufoff) + ldsw + _i * 8192), 16, 0, 0); } while (0)
#define PG8_LDA(dst, b, h) do { _Pragma("unroll") for (int m = 0; m < 4; ++m) _Pragma("unroll") for (int k = 0; k < 2; ++k) dst[m][k] = *(const PG8_LAS bf16x8*)(lds + PG8_SA(b, h) + aoff + m * 2048 + k * 1024); } while (0)
#define PG8_LDB(dst, b, h) do { _Pragma("unroll") for (int n = 0; n < 2; ++n) _Pragma("unroll") for (int k = 0; k < 2; ++k) dst[n][k] = *(const PG8_LAS bf16x8*)(lds + PG8_SB(b, h) + boff + n * 2048 + k * 1024); } while (0)
#define PG8_MMA(ai, bj, At, Bt) do { __builtin_amdgcn_s_setprio(1); _Pragma("unroll") for (int m = 0; m < 4; ++m) _Pragma("unroll") for (int n = 0; n < 2; ++n) _Pragma("unroll") for (int k = 0; k < 2; ++k) \
        acc[ai][bj][m][n] = __builtin_amdgcn_mfma_f32_16x16x32_bf16(Bt[n][k], At[m][k], acc[ai][bj][m][n], 0, 0, 0); __builtin_amdgcn_s_setprio(0); } while (0)
#define PG8_WAIT_V(n) asm volatile("s_waitcnt vmcnt(" #n ")" ::: "memory")
#define PG8_WAIT_L(n) asm volatile("s_waitcnt lgkmcnt(" #n ")" ::: "memory")
#define PG8_BAR __builtin_amdgcn_s_barrier()
#define PG8_SCHED __builtin_amdgcn_sched_barrier(0)
    Unit cur, nxt; int ui = 0;
    if (!S.next(0, cur)) return;
    f32x4 acc[2][2][4][2];
#pragma unroll
    for (int a = 0; a < 2; ++a)
#pragma unroll
        for (int b = 0; b < 2; ++b)
#pragma unroll
            for (int m = 0; m < 4; ++m)
#pragma unroll
                for (int n = 0; n < 2; ++n) acc[a][b][m][n] = (f32x4){0.f, 0.f, 0.f, 0.f};
    bf16x8 At[4][2], B0[2][2], B1[2][2];
    const char* cA = (const char*)g.A + (size_t)cur.pm * tstep; const char* cB = (const char*)g.Bt + (size_t)cur.pn * tstep;
    S.a_ready(cur);
    PG8_STAGE(PG8_SB(0, 0), cB, voffB); PG8_STAGE(PG8_SA(0, 0), cA, voffA); PG8_STAGE(PG8_SB(0, 1), cB + hstep, voffB); PG8_STAGE(PG8_SA(0, 1), cA + hstep, voffA);
    if (wr == 1) PG8_BAR;
    PG8_WAIT_V(4); PG8_BAR;
    PG8_STAGE(PG8_SB(1, 0), cB + kstep, voffB); PG8_STAGE(PG8_SA(1, 0), cA + kstep, voffA); PG8_STAGE(PG8_SB(1, 1), cB + hstep + kstep, voffB);
    PG8_WAIT_V(6); PG8_BAR;
    for (;;) {
        const bool has_next = S.next(ui + 1, nxt);
        const char* nA = has_next ? (const char*)g.A + (size_t)nxt.pm * tstep : cA; const char* nB = has_next ? (const char*)g.Bt + (size_t)nxt.pn * tstep : cB;
        for (int t = 0; t < nt; t += 2) {
            const bool last = (t == nt - 2);
            const char* a1 = cA + (size_t)(t + 1) * kstep;
            const char* a2 = last ? nA : cA + (size_t)(t + 2) * kstep; const char* b2 = last ? nB : cB + (size_t)(t + 2) * kstep;
            const char* a3 = a2 + kstep; const char* b3 = b2 + kstep;
            if (last && has_next) S.a_ready(nxt);
            PG8_LDB(B0, 0, 0); PG8_SCHED; PG8_LDA(At, 0, 0); PG8_STAGE(PG8_SA(1, 1), a1 + hstep, voffA);
            PG8_WAIT_L(8); PG8_BAR; PG8_WAIT_L(0); PG8_MMA(0, 0, At, B0); PG8_BAR; PG8_SCHED;
            PG8_LDB(B1, 0, 1); PG8_STAGE(PG8_SB(0, 0), b2, voffB);
            PG8_BAR; PG8_WAIT_L(0); PG8_MMA(0, 1, At, B1); PG8_BAR;
            PG8_LDA(At, 0, 1); PG8_STAGE(PG8_SA(0, 0), a2, voffA);
            PG8_BAR; PG8_WAIT_L(0); PG8_MMA(1, 0, At, B0); PG8_BAR; PG8_SCHED;
            PG8_STAGE(PG8_SB(0, 1), b2 + hstep, voffB);
            PG8_WAIT_V(6); PG8_BAR; PG8_MMA(1, 1, At, B1); PG8_BAR;
            PG8_LDB(B0, 1, 0); PG8_SCHED; PG8_LDA(At, 1, 0); PG8_STAGE(PG8_SA(0, 1), a2 + hstep, voffA);
            PG8_WAIT_L(8); PG8_BAR; PG8_WAIT_L(0); PG8_MMA(0, 0, At, B0); PG8_BAR; PG8_SCHED;
            PG8_LDB(B1, 1, 1); PG8_STAGE(PG8_SB(1, 0), b3, voffB);
            PG8_BAR; PG8_WAIT_L(0); PG8_MMA(0, 1, At, B1); PG8_BAR;
            PG8_LDA(At, 1, 1); PG8_STAGE(PG8_SA(1, 0), a3, voffA);
            PG8_BAR; PG8_WAIT_L(0); PG8_MMA(1, 0, At, B0); PG8_BAR; PG8_SCHED;
            PG8_STAGE(PG8_SB(1, 1), b3 + hstep, voffB);
            PG8_WAIT_V(6); PG8_BAR; PG8_MMA(1, 1, At, B1); PG8_BAR;
        }
        E(acc, cur, wr, wc, fr, fq); S.done(cur);
        if (!has_next) break;
#pragma unroll
        for (int a = 0; a < 2; ++a)
#pragma unroll
            for (int b = 0; b < 2; ++b)
#pragma unroll
                for (int m = 0; m < 4; ++m)
#pragma unroll
                    for (int n = 0; n < 2; ++n) acc[a][b][m][n] = (f32x4){0.f, 0.f, 0.f, 0.f};
        cur = nxt; cA = nA; cB = nB; ++ui;
    }
    PG8_WAIT_V(0);
    if (wr == 0) PG8_BAR;
    PG8_BAR;
#undef PG8_SA
#undef PG8_SB
#undef PG8_STAGE
#undef PG8_LDA
#undef PG8_LDB
#undef PG8_MMA
#undef PG8_WAIT_V
#undef PG8_WAIT_L
#undef PG8_BAR
#undef PG8_SCHED
}
}
using pg8::Unit;

__device__ __forceinline__ u32x4 pack8(const f32x4 a, const f32x4 b) { u32x4 w; w.x = pk2(a[0], a[1]); w.y = pk2(a[2], a[3]); w.z = pk2(b[0], b[1]); w.w = pk2(b[2], b[3]); return w; }

struct EpiIn {
    static constexpr bool PERM = true;
    bf16_t *Z, *XBC, *Q, *KP, *VP, *KS, *VS, *GT; float* DT; float* out; const float* dt_bias;
    __device__ __forceinline__ void operator()(const f32x4 (&acc)[2][2][4][2], const Unit& u, int wr, int wc, int fr, int fq) const {
        const int pn = u.pn;
        const int rbase = u.pm * 256 + wr * 64 + fr, cl = wc * 32 + 8 * fq;
#pragma unroll
        for (int ai = 0; ai < 2; ++ai)
#pragma unroll
            for (int m = 0; m < 4; ++m) {
                const int row = rbase + ai * 128 + m * 16;
#pragma unroll
                for (int bj = 0; bj < 2; ++bj) {
                    const int cloc = cl + bj * 128;
                    f32x4 v0 = acc[ai][bj][m][0], v1 = acc[ai][bj][m][1];
                    if (pn < 16) {
                        *(u32x4*)(Z + (size_t)row * SI + pn * 256 + cloc) = pack8(v0, v1);
                    } else if (pn < 40) {
                        const int c = (pn - 16) * 256 + cloc;
                        *(u32x4*)(XBC + (size_t)row * CD + c) = pack8(v0, v1);
                        float* o = nullptr;
                        if (row < MP) { if (row >= MP - 3) o = out + O_CONVP + (size_t)(row - (MP - 3)) * CD + c; }
                        else { const int t = (row - MP) & 63, b = (row - MP) >> 6; if (t >= 61) o = out + O_CONVS + (size_t)(b * 3 + t - 61) * CD + c; }
                        if (o) { *(f32x4*)o = v0; *(f32x4*)(o + 4) = v1; }
                    } else if (pn < 48) {
                        *(u32x4*)(Q + (size_t)row * DM + (pn - 40) * 256 + cloc) = pack8(v0, v1);
                    } else if (pn < 64) {
                        const bool isk = pn < 56;
                        const int c = (pn - (isk ? 48 : 56)) * 256 + cloc;
                        bf16_t* d; float* o = nullptr;
                        if (row < MP) { d = (isk ? KP : VP) + (size_t)row * DM + c; if (row >= MP - 512) o = out + (isk ? O_KP : O_VP) + (size_t)(row - (MP - 512)) * DM + c; }
                        else { const int t = (row - MP) & 63, b = (row - MP) >> 6; d = (isk ? KS : VS) + ((size_t)b * 576 + 512 + t) * DM + c; o = out + (isk ? O_KS : O_VS) + (size_t)(row - MP) * DM + c; }
                        *(u32x4*)d = pack8(v0, v1);
                        if (o) { *(f32x4*)o = v0; *(f32x4*)(o + 4) = v1; }
                    } else if (pn < 80) {
#pragma unroll
                        for (int j = 0; j < 4; ++j) { v0[j] = fsig(v0[j]); v1[j] = fsig(v1[j]); }
                        *(u32x4*)(GT + (size_t)row * 4096 + (pn - 64) * 256 + cloc) = pack8(v0, v1);
                    } else {
                        if (cloc < 64) {
                            const f32x4 b0 = *(const f32x4*)(dt_bias + cloc), b1 = *(const f32x4*)(dt_bias + cloc + 4);
#pragma unroll
                            for (int j = 0; j < 4; ++j) { float a = v0[j] + b0[j]; v0[j] = a > 20.f ? a : log1pf(__expf(a)); float c2 = v1[j] + b1[j]; v1[j] = c2 > 20.f ? c2 : log1pf(__expf(c2)); }
                            *(f32x4*)(DT + (size_t)row * 64 + cloc) = v0; *(f32x4*)(DT + (size_t)row * 64 + cloc + 4) = v1;
                        }
                    }
                }
            }
    }
};

struct EpiSsdOut {
    static constexpr bool PERM = false;
    float* part; const bf16_t* GT;
    __device__ __forceinline__ void operator()(const f32x4 (&acc)[2][2][4][2], const Unit& u, int wr, int wc, int fr, int fq) const {
        const int rbase = u.pm * 256 + wr * 64 + fr, cbase = u.pn * 256 + wc * 32 + 4 * fq;
#pragma unroll
        for (int ai = 0; ai < 2; ++ai)
#pragma unroll
            for (int m = 0; m < 4; ++m) {
                const int row = rbase + ai * 128 + m * 16;
#pragma unroll
                for (int bj = 0; bj < 2; ++bj)
#pragma unroll
                    for (int n = 0; n < 2; ++n) {
                        const int col = cbase + bj * 128 + n * 16;
                        const u32x2 g = *(const u32x2*)(GT + (size_t)row * 4096 + col);
                        f32x4 v = acc[ai][bj][m][n];
                        v[0] *= lo2f(g.x); v[1] *= hi2f(g.x); v[2] *= lo2f(g.y); v[3] *= hi2f(g.y);
                        *(f32x4*)(part + (size_t)row * DM + col) = v;
                    }
            }
    }
};
struct EpiAttOut {
    static constexpr bool PERM = false;
    const float* part; const bf16_t* GT; bf16_t* MIXED;
    __device__ __forceinline__ void operator()(const f32x4 (&acc)[2][2][4][2], const Unit& u, int wr, int wc, int fr, int fq) const {
        const int rbase = u.pm * 256 + wr * 64 + fr, cbase = u.pn * 256 + wc * 32 + 4 * fq;
#pragma unroll
        for (int ai = 0; ai < 2; ++ai)
#pragma unroll
            for (int m = 0; m < 4; ++m) {
                const int row = rbase + ai * 128 + m * 16;
#pragma unroll
                for (int bj = 0; bj < 2; ++bj)
#pragma unroll
                    for (int n = 0; n < 2; ++n) {
                        const int col = cbase + bj * 128 + n * 16;
                        const u32x2 g = *(const u32x2*)(GT + (size_t)row * 4096 + 2048 + col);
                        const f32x4 pv = *(const f32x4*)(part + (size_t)row * DM + col);
                        f32x4 v = acc[ai][bj][m][n];
                        v[0] = pv[0] + v[0] * lo2f(g.x); v[1] = pv[1] + v[1] * hi2f(g.x); v[2] = pv[2] + v[2] * lo2f(g.y); v[3] = pv[3] + v[3] * hi2f(g.y);
                        u32x2 w; w.x = pk2(v[0], v[1]); w.y = pk2(v[2], v[3]);
                        *(u32x2*)(MIXED + (size_t)row * DM + col) = w;
                    }
            }
    }
};
struct EpiResid {
    static constexpr bool PERM = false;
    const float* resP; const float* resS; float* dst;
    __device__ __forceinline__ void operator()(const f32x4 (&acc)[2][2][4][2], const Unit& u, int wr, int wc, int fr, int fq) const {
        const int rbase = u.pm * 256 + wr * 64 + fr, cbase = u.pn * 256 + wc * 32 + 4 * fq;
#pragma unroll
        for (int ai = 0; ai < 2; ++ai)
#pragma unroll
            for (int m = 0; m < 4; ++m) {
                const int row = rbase + ai * 128 + m * 16;
                const float* rp = row < MP ? resP + (size_t)row * DM : resS + (size_t)(row - MP) * DM;
#pragma unroll
                for (int bj = 0; bj < 2; ++bj)
#pragma unroll
                    for (int n = 0; n < 2; ++n) {
                        const int col = cbase + bj * 128 + n * 16;
                        const f32x4 r = *(const f32x4*)(rp + col);
                        *(f32x4*)(dst + (size_t)row * DM + col) = acc[ai][bj][m][n] + r * ALPHA;
                    }
            }
    }
};
struct EpiGateUp {
    static constexpr bool PERM = false;
    bf16_t* ACT;
    __device__ __forceinline__ void operator()(const f32x4 (&acc)[2][2][4][2], const Unit& u, int wr, int wc, int fr, int fq) const {
        const int rbase = u.pm * 256 + wr * 64 + fr, cbase = u.pn * 128 + wc * 16 + 4 * fq;
#pragma unroll
        for (int ai = 0; ai < 2; ++ai)
#pragma unroll
            for (int m = 0; m < 4; ++m) {
                const int row = rbase + ai * 128 + m * 16;
#pragma unroll
                for (int bj = 0; bj < 2; ++bj) {
                    const f32x4 gt = acc[ai][bj][m][0], up = acc[ai][bj][m][1];
                    u32x2 w; w.x = pk2(fsilu(gt[0]) * up[0], fsilu(gt[1]) * up[1]); w.y = pk2(fsilu(gt[2]) * up[2], fsilu(gt[3]) * up[3]);
                    *(u32x2*)(ACT + (size_t)row * DFF + cbase + bj * 64) = w;
                }
            }
    }
};

template <int MAP> __device__ __forceinline__ int srccol(int n) {
    if (MAP == 0) return n;
    if (MAP == 1) { if (n < 10240) return n; if (n < 20480) return n + 64; if (n < 20544) return n - 20480 + 10240; return -1; }
    const int pn = n >> 8, c = n & 255;
    return ((c & 16) ? DFF : 0) + 128 * pn + 64 * (c >> 7) + 16 * ((c >> 5) & 3) + (c & 15);
}
template <int MAP> __device__ __forceinline__ void tr_cvt(const float* __restrict__ src, int ldsrc, int K, bf16_t* __restrict__ dst, int Nd) {
    float* T = (float*)g_lds;
    const int tid = threadIdx.x, tx = tid & 63, ty = tid >> 6, kx2 = (tid & 31) * 2, ny = tid >> 5;
    const int ntn = Nd / 64, ntiles = ntn * (K / 64);
    for (int tile = blockIdx.x; tile < ntiles; tile += gridDim.x) {
        const int n0 = (tile % ntn) * 64, k0 = (tile / ntn) * 64;
        const int sc = srccol<MAP>(n0 + tx);
#pragma unroll
        for (int kk = ty; kk < 64; kk += 8) T[kk * 65 + tx] = sc >= 0 ? src[(size_t)(k0 + kk) * ldsrc + sc] : 0.f;
        __syncthreads();
#pragma unroll
        for (int nn = ny; nn < 64; nn += 16) *(unsigned*)(dst + (size_t)(n0 + nn) * K + k0 + kx2) = pk2(T[kx2 * 65 + nn], T[(kx2 + 1) * 65 + nn]);
        __syncthreads();
    }
}

__device__ __forceinline__ void phase0(const Params& p) {
    const size_t gt = (size_t)blockIdx.x * 512 + threadIdx.x, gs = (size_t)gridDim.x * 512;
    bf16_t* XB = (bf16_t*)(p.ws + OFF_XB);
    for (size_t i = gt; i < (size_t)MT * 256; i += gs) {
        const size_t row = i >> 8; const int c8 = (int)(i & 255) * 8;
        const float* s = row < MP ? p.in[0] + row * DM + c8 : p.in[1] + (row - MP) * DM + c8;
        *(u32x4*)(XB + row * DM + c8) = cvt8(s);
    }
    bf16_t* KS = (bf16_t*)(p.ws + OFF_KSB); bf16_t* VS = (bf16_t*)(p.ws + OFF_VSB);
    for (size_t i = gt; i < (size_t)16 * 512 * 256; i += gs) {
        const size_t b = i / (512 * 256), rem = i % (512 * 256), j = rem >> 8; const int c8 = (int)(rem & 255) * 8;
        const size_t so = (b * 512 + j) * DM + c8, dof = (b * 576 + j) * DM + c8;
        *(u32x4*)(KS + dof) = cvt8(p.in[2] + so); *(u32x4*)(VS + dof) = cvt8(p.in[3] + so);
    }
    tr_cvt<1>(p.in[6], NIN_SRC, DM, (bf16_t*)(p.ws + OFF_WIN), NIN);
    tr_cvt<0>(p.in[14], DM, SI, (bf16_t*)(p.ws + OFF_WSSD), DM);
    tr_cvt<0>(p.in[15], DM, DM, (bf16_t*)(p.ws + OFF_WATT), DM);
    tr_cvt<0>(p.in[16], DM, DM, (bf16_t*)(p.ws + OFF_WO), DM);
}

__device__ __forceinline__ void unpack8(const u32x4 v, float (&f)[8]) { f[0] = lo2f(v.x); f[1] = hi2f(v.x); f[2] = lo2f(v.y); f[3] = hi2f(v.y); f[4] = lo2f(v.z); f[5] = hi2f(v.z); f[6] = lo2f(v.w); f[7] = hi2f(v.w); }
__device__ __forceinline__ void load8f(const float* s, float (&f)[8]) { const f32x4 a = *(const f32x4*)s, b = *(const f32x4*)(s + 4); f[0] = a[0]; f[1] = a[1]; f[2] = a[2]; f[3] = a[3]; f[4] = b[0]; f[5] = b[1]; f[6] = b[2]; f[7] = b[3]; }
__device__ __forceinline__ void conv_phase(const Params& p) {
    const size_t gt = (size_t)blockIdx.x * 512 + threadIdx.x, gs = (size_t)gridDim.x * 512;
    const bf16_t* XBC = (const bf16_t*)(p.ws + OFF_XBC); bf16_t* XC = (bf16_t*)(p.ws + OFF_XC);
    const float* cw = p.in[7]; const float* cb = p.in[8]; const float* sc = p.in[4];
    for (size_t it = gt; it < (size_t)576 * 768; it += gs) {
        const int cgi = (int)(it % 768), rb = (int)(it / 768), c = cgi * 8, r0 = rb * 16;
        float w0[8], w1[8], w2[8], w3[8], bb[8], h0[8], h1[8], h2[8];
        load8f(cw + c, w0); load8f(cw + CD + c, w1); load8f(cw + 2 * CD + c, w2); load8f(cw + 3 * CD + c, w3); load8f(cb + c, bb);
        const bool sstart = (r0 >= MP) && (((r0 - MP) & 63) == 0);
        if (r0 == 0) {
#pragma unroll
            for (int k = 0; k < 8; ++k) { h0[k] = 0.f; h1[k] = 0.f; h2[k] = 0.f; }
        } else if (sstart) {
            const int b = (r0 - MP) >> 6;
            load8f(sc + (size_t)(b * 3 + 0) * CD + c, h0); load8f(sc + (size_t)(b * 3 + 1) * CD + c, h1); load8f(sc + (size_t)(b * 3 + 2) * CD + c, h2);
        } else {
            unpack8(*(const u32x4*)(XBC + (size_t)(r0 - 3) * CD + c), h0); unpack8(*(const u32x4*)(XBC + (size_t)(r0 - 2) * CD + c), h1); unpack8(*(const u32x4*)(XBC + (size_t)(r0 - 1) * CD + c), h2);
        }
#pragma unroll 4
        for (int rr = 0; rr < 16; ++rr) {
            float cur[8], o[8];
            unpack8(*(const u32x4*)(XBC + (size_t)(r0 + rr) * CD + c), cur);
#pragma unroll
            for (int k = 0; k < 8; ++k) { o[k] = fsilu(bb[k] + h0[k] * w0[k] + h1[k] * w1[k] + h2[k] * w2[k] + cur[k] * w3[k]); h0[k] = h1[k]; h1[k] = h2[k]; h2[k] = cur[k]; }
            u32x4 w; w.x = pk2(o[0], o[1]); w.y = pk2(o[2], o[3]); w.z = pk2(o[4], o[5]); w.w = pk2(o[6], o[7]);
            *(u32x4*)(XC + (size_t)(r0 + rr) * CD + c) = w;
        }
    }
}

__device__ __forceinline__ void ssd_phase(const Params& p) {
    const int tid = threadIdx.x, lane = tid & 63, w = tid >> 6, l15 = lane & 15, lq = lane >> 4;
    bf16_t* Bn = (bf16_t*)(g_lds);
    bf16_t* Cn = (bf16_t*)(g_lds + 17408);
    bf16_t* Xt = (bf16_t*)(g_lds + 34816);
    bf16_t* Xw = (bf16_t*)(g_lds + 37120);
    bf16_t* Mm = (bf16_t*)(g_lds + 39424);
    bf16_t* Hh = (bf16_t*)(g_lds + 48640);
    float* fcs = (float*)(g_lds + 52992);
    float* fdt = fcs + 64; float* fwj = fcs + 128; float* fec = fcs + 192; float* fms = fcs + 256;
    const bf16_t* XC = (const bf16_t*)(p.ws + OFF_XC); const float* DT = (const float*)(p.ws + OFF_DT);
    bf16_t* Y = (bf16_t*)(p.ws + OFF_Y);
    for (int item = blockIdx.x; item < 256; item += gridDim.x) {
        const int head = item >> 2, pq = item & 3, g = head >> 3;
        const float a_h = -__expf(p.in[10][head]), dskip = p.in[11][head];
        u32x4 rb[2], rc[2], rx; float rdt = 0.f;
        f32x4 hacc[2]; hacc[0] = (f32x4){0.f, 0.f, 0.f, 0.f}; hacc[1] = hacc[0];
        __syncthreads();
        if (w >= 4) {
#pragma unroll
            for (int tt = 0; tt < 2; ++tt)
#pragma unroll
                for (int e = 0; e < 4; ++e) Hh[(lq * 4 + e) * 136 + ((w - 4) * 2 + tt) * 16 + l15] = 0;
        }
#define SSD_LOAD(s_) do { const size_t R0_ = (size_t)(s_) * 64; \
            _Pragma("unroll") for (int e = 0; e < 2; ++e) { const int v = tid + 512 * e, j = v >> 4, n8 = (v & 15) * 8; \
                rb[e] = *(const u32x4*)(XC + (R0_ + j) * CD + 4096 + g * 128 + n8); rc[e] = *(const u32x4*)(XC + (R0_ + j) * CD + 5120 + g * 128 + n8); } \
            if (tid < 128) rx = *(const u32x4*)(XC + (R0_ + (tid >> 1)) * CD + head * 64 + pq * 16 + (tid & 1) * 8); \
            if (tid < 64) rdt = DT[(R0_ + tid) * 64 + head]; } while (0)
        SSD_LOAD(0);
        for (int s = 0; s < 144; ++s) {
            const size_t R0 = (size_t)s * 64;
#pragma unroll
            for (int e = 0; e < 2; ++e) { const int v = tid + 512 * e, j = v >> 4, n8 = (v & 15) * 8;
                *(u32x4*)(Bn + j * 136 + n8) = rb[e]; *(u32x4*)(Cn + j * 136 + n8) = rc[e]; }
            if (tid < 128) { const int j = tid >> 1, p8 = (tid & 1) * 8;
                Xt[(p8 + 0) * 72 + j] = (bf16_t)(rx.x & 0xffff); Xt[(p8 + 1) * 72 + j] = (bf16_t)(rx.x >> 16);
                Xt[(p8 + 2) * 72 + j] = (bf16_t)(rx.y & 0xffff); Xt[(p8 + 3) * 72 + j] = (bf16_t)(rx.y >> 16);
                Xt[(p8 + 4) * 72 + j] = (bf16_t)(rx.z & 0xffff); Xt[(p8 + 5) * 72 + j] = (bf16_t)(rx.z >> 16);
                Xt[(p8 + 6) * 72 + j] = (bf16_t)(rx.w & 0xffff); Xt[(p8 + 7) * 72 + j] = (bf16_t)(rx.w >> 16); }
            if (w == 0) {
                float x = rdt * a_h;
#pragma unroll
                for (int off = 1; off < 64; off <<= 1) { const float y = __shfl_up(x, off, 64); if (lane >= off) x += y; }
                const float last = __shfl(x, 63, 64);
                fcs[lane] = x; fdt[lane] = rdt; fwj[lane] = __expf(last - x) * rdt; fec[lane] = __expf(x);
                if (lane == 63) fms[0] = __expf(x);
            }
            __syncthreads();
            if (s + 1 < 144) SSD_LOAD(s + 1);
            {
                const int it = w >> 1;
#pragma unroll
                for (int tj = 0; tj < 2; ++tj) {
                    const int jt = (w & 1) * 2 + tj;
                    f32x4 acc = (f32x4){0.f, 0.f, 0.f, 0.f};
#pragma unroll
                    for (int nk = 0; nk < 4; ++nk) {
                        const bf16x8 A = *(const bf16x8*)(Cn + (it * 16 + l15) * 136 + nk * 32 + lq * 8);
                        const bf16x8 B = *(const bf16x8*)(Bn + (jt * 16 + l15) * 136 + nk * 32 + lq * 8);
                        acc = mfma16(A, B, acc);
                    }
                    const int j = jt * 16 + l15; const float csj = fcs[j], dtj = fdt[j];
#pragma unroll
                    for (int e = 0; e < 4; ++e) { const int i = it * 16 + lq * 4 + e;
                        const float v = (j <= i) ? acc[e] * __expf(fcs[i] - csj) * dtj : 0.f;
                        Mm[i * 72 + j] = f2bf(v); }
                }
#pragma unroll
                for (int e = 0; e < 2; ++e) { const int idx = tid + 512 * e, pp = idx >> 6, j = idx & 63; Xw[pp * 72 + j] = f2bf(bf2f(Xt[pp * 72 + j]) * fwj[j]); }
            }
            __syncthreads();
            if (w < 4) {
                const int it = w;
                f32x4 accd = (f32x4){0.f, 0.f, 0.f, 0.f}, acco = accd;
#pragma unroll
                for (int jk = 0; jk < 2; ++jk) {
                    const bf16x8 A = *(const bf16x8*)(Mm + (it * 16 + l15) * 72 + jk * 32 + lq * 8);
                    const bf16x8 B = *(const bf16x8*)(Xt + l15 * 72 + jk * 32 + lq * 8);
                    accd = mfma16(A, B, accd);
                }
#pragma unroll
                for (int nk = 0; nk < 4; ++nk) {
                    const bf16x8 A = *(const bf16x8*)(Cn + (it * 16 + l15) * 136 + nk * 32 + lq * 8);
                    const bf16x8 B = *(const bf16x8*)(Hh + l15 * 136 + nk * 32 + lq * 8);
                    acco = mfma16(A, B, acco);
                }
#pragma unroll
                for (int e = 0; e < 4; ++e) { const int i = it * 16 + lq * 4 + e;
                    const float yv = accd[e] + fec[i] * acco[e] + dskip * bf2f(Xt[l15 * 72 + i]);
                    Y[(R0 + i) * SI + head * 64 + pq * 16 + l15] = f2bf(yv); }
            } else {
                const float cdec = fms[0];
#pragma unroll
                for (int tt = 0; tt < 2; ++tt) {
                    const int nt = (w - 4) * 2 + tt;
                    hacc[tt] *= cdec;
#pragma unroll
                    for (int jk = 0; jk < 2; ++jk) {
                        const bf16x8 A = *(const bf16x8*)(Xw + l15 * 72 + jk * 32 + lq * 8);
                        bf16x8 B;
#pragma unroll
                        for (int e = 0; e < 8; ++e) B[e] = (short)Bn[(jk * 32 + lq * 8 + e) * 136 + nt * 16 + l15];
                        hacc[tt] = mfma16(A, B, hacc[tt]);
                    }
                }
            }
            __syncthreads();
            if (w >= 4) {
                if (s >= 127) {
                    float* dst = (s == 127) ? p.out + O_SSMP + ((size_t)head * 64 + pq * 16) * 128
                                            : p.out + O_SSMS + (((size_t)(s - 128) * 64 + head) * 64 + pq * 16) * 128;
#pragma unroll
                    for (int tt = 0; tt < 2; ++tt)
#pragma unroll
                        for (int e = 0; e < 4; ++e) dst[(lq * 4 + e) * 128 + ((w - 4) * 2 + tt) * 16 + l15] = hacc[tt][e];
                    if (s + 1 < 144) {
                        const float* src = p.in[5] + (((size_t)(s + 1 - 128) * 64 + head) * 64 + pq * 16) * 128;
#pragma unroll
                        for (int tt = 0; tt < 2; ++tt)
#pragma unroll
                            for (int e = 0; e < 4; ++e) hacc[tt][e] = src[(lq * 4 + e) * 128 + ((w - 4) * 2 + tt) * 16 + l15];
                    }
                }
#pragma unroll
                for (int tt = 0; tt < 2; ++tt)
#pragma unroll
                    for (int e = 0; e < 4; ++e) Hh[(lq * 4 + e) * 136 + ((w - 4) * 2 + tt) * 16 + l15] = f2bf(hacc[tt][e]);
            }
        }
#undef SSD_LOAD
    }
}

__device__ __forceinline__ int vt_addr(int d, int key) { return d * 64 + ((((key >> 2) ^ (d ^ (d >> 3))) & 15) << 2) + (key & 3); }
__device__ __forceinline__ void attn_phase(const Params& p) {
    const int tid = threadIdx.x, hw = tid >> 8, ht = tid & 255, lane = tid & 63, wq = (tid >> 6) & 3, l15 = lane & 15, lq = lane >> 4;
    unsigned char* hb = g_lds + hw * 36992;
    bf16_t* Ks = (bf16_t*)hb;
    bf16_t* Vt = (bf16_t*)(hb + 17408);
    float* bs = (float*)(hb + 33792);
    const bf16_t* Qg = (const bf16_t*)(p.ws + OFF_Q);
    bf16_t* ATT = (bf16_t*)(p.ws + OFF_ATT);
    const float scale = 0.08838834764831845f;
    for (int pi = blockIdx.x; pi < 1152; pi += gridDim.x) {
        const int u = pi * 2 + hw, head = u & 15;
        int qrow0, krow0; const bf16_t* Kg; const bf16_t* Vg;
        if (u < 2048) { const int n = u >> 4; qrow0 = n * 64; krow0 = n * 64 - 512; Kg = (const bf16_t*)(p.ws + OFF_KPB); Vg = (const bf16_t*)(p.ws + OFF_VPB); }
        else { const int b = (u - 2048) >> 4; qrow0 = MP + b * 64; krow0 = 0; Kg = (const bf16_t*)(p.ws + OFF_KSB) + (size_t)b * 576 * DM; Vg = (const bf16_t*)(p.ws + OFF_VSB) + (size_t)b * 576 * DM; }
        __syncthreads();
        for (int i = ht; i < 257; i += 256) bs[i] = p.in[13][head * 257 + i];
        bf16x8 Qf[4];
        { const bf16_t* qp = Qg + (size_t)(qrow0 + wq * 16 + l15) * DM + head * 128 + lq * 8;
#pragma unroll
          for (int ks = 0; ks < 4; ++ks) Qf[ks] = *(const bf16x8*)(qp + ks * 32); }
        float mrun = -INFINITY, lrun = 0.f;
        f32x4 o[8];
#pragma unroll
        for (int db = 0; db < 8; ++db) o[db] = (f32x4){0.f, 0.f, 0.f, 0.f};
        u32x4 rk[4], rv[4];
#define ATT_LOAD(t_) do { const int kr_ = krow0 + (t_) * 64; if (kr_ >= 0) { \
            _Pragma("unroll") for (int e = 0; e < 4; ++e) { const int v = ht + 256 * e; rk[e] = *(const u32x4*)(Kg + (size_t)(kr_ + (v >> 4)) * DM + head * 128 + (v & 15) * 8); } \
            _Pragma("unroll") for (int e2 = 0; e2 < 2; ++e2) { const int kp = (ht >> 4) + 16 * e2; \
                rv[e2 * 2] = *(const u32x4*)(Vg + (size_t)(kr_ + 2 * kp) * DM + head * 128 + (ht & 15) * 8); rv[e2 * 2 + 1] = *(const u32x4*)(Vg + (size_t)(kr_ + 2 * kp + 1) * DM + head * 128 + (ht & 15) * 8); } } } while (0)
        ATT_LOAD(8);
        for (int itl = 0; itl < 9; ++itl) {
            const int t = itl == 0 ? 8 : itl - 1;
            const bool valid = (krow0 + t * 64) >= 0;
            __syncthreads();
            if (valid) {
#pragma unroll
                for (int e = 0; e < 4; ++e) { const int v = ht + 256 * e; *(u32x4*)(Ks + (v >> 4) * 136 + (v & 15) * 8) = rk[e]; }
#pragma unroll
                for (int e2 = 0; e2 < 2; ++e2) { const int kp = (ht >> 4) + 16 * e2, d0 = (ht & 15) * 8; const u32x4 a = rv[e2 * 2], b = rv[e2 * 2 + 1];
                    *(unsigned*)(Vt + vt_addr(d0 + 0, 2 * kp)) = (a.x & 0xffffu) | (b.x << 16); *(unsigned*)(Vt + vt_addr(d0 + 1, 2 * kp)) = (a.x >> 16) | (b.x & 0xffff0000u);
                    *(unsigned*)(Vt + vt_addr(d0 + 2, 2 * kp)) = (a.y & 0xffffu) | (b.y << 16); *(unsigned*)(Vt + vt_addr(d0 + 3, 2 * kp)) = (a.y >> 16) | (b.y & 0xffff0000u);
                    *(unsigned*)(Vt + vt_addr(d0 + 4, 2 * kp)) = (a.z & 0xffffu) | (b.z << 16); *(unsigned*)(Vt + vt_addr(d0 + 5, 2 * kp)) = (a.z >> 16) | (b.z & 0xffff0000u);
                    *(unsigned*)(Vt + vt_addr(d0 + 6, 2 * kp)) = (a.w & 0xffffu) | (b.w << 16); *(unsigned*)(Vt + vt_addr(d0 + 7, 2 * kp)) = (a.w >> 16) | (b.w & 0xffff0000u); }
            }
            __syncthreads();
            if (itl + 1 < 9) ATT_LOAD(itl);
            if (valid) {
                f32x4 sc[4];
#pragma unroll
                for (int kt = 0; kt < 4; ++kt) { sc[kt] = (f32x4){0.f, 0.f, 0.f, 0.f};
#pragma unroll
                    for (int ks = 0; ks < 4; ++ks) { const bf16x8 A = *(const bf16x8*)(Ks + (kt * 16 + l15) * 136 + ks * 32 + lq * 8); sc[kt] = mfma16(A, Qf[ks], sc[kt]); } }
                const int qi = wq * 16 + l15;
                float tmax = -INFINITY;
#pragma unroll
                for (int kt = 0; kt < 4; ++kt)
#pragma unroll
                    for (int e = 0; e < 4; ++e) { const int j = t * 64 + kt * 16 + lq * 4 + e; int rel = qi - j + 512; rel = rel < -128 ? -128 : (rel > 128 ? 128 : rel);
                        const float sv = sc[kt][e] * scale + bs[rel + 128]; sc[kt][e] = sv; tmax = fmaxf(tmax, sv); }
                tmax = fmaxf(tmax, __shfl_xor(tmax, 16, 64)); tmax = fmaxf(tmax, __shfl_xor(tmax, 32, 64));
                const float mnew = fmaxf(mrun, tmax), alpha = __expf(mrun - mnew);
                float psum = 0.f;
#pragma unroll
                for (int kt = 0; kt < 4; ++kt)
#pragma unroll
                    for (int e = 0; e < 4; ++e) { const float pv = __expf(sc[kt][e] - mnew); sc[kt][e] = pv; psum += pv; }
                psum += __shfl_xor(psum, 16, 64); psum += __shfl_xor(psum, 32, 64);
                lrun = lrun * alpha + psum; mrun = mnew;
#pragma unroll
                for (int db = 0; db < 8; ++db) o[db] *= alpha;
                bf16x8 Bp[2];
#pragma unroll
                for (int k2 = 0; k2 < 2; ++k2) { u32x4 w; w.x = pk2(sc[2 * k2][0], sc[2 * k2][1]); w.y = pk2(sc[2 * k2][2], sc[2 * k2][3]); w.z = pk2(sc[2 * k2 + 1][0], sc[2 * k2 + 1][1]); w.w = pk2(sc[2 * k2 + 1][2], sc[2 * k2 + 1][3]);
                    Bp[k2] = __builtin_bit_cast(bf16x8, w); }
#pragma unroll
                for (int db = 0; db < 8; ++db)
#pragma unroll
                    for (int k2 = 0; k2 < 2; ++k2) { const int d = db * 16 + l15;
                        const u32x2 lo = *(const u32x2*)(Vt + vt_addr(d, (2 * k2) * 16 + lq * 4)), hi = *(const u32x2*)(Vt + vt_addr(d, (2 * k2 + 1) * 16 + lq * 4));
                        u32x4 w; w.x = lo.x; w.y = lo.y; w.z = hi.x; w.w = hi.y;
                        o[db] = mfma16(__builtin_bit_cast(bf16x8, w), Bp[k2], o[db]); }
            }
        }
#undef ATT_LOAD
        const float inv = 1.0f / lrun;
        bf16_t* op = ATT + (size_t)(qrow0 + wq * 16 + l15) * DM + head * 128 + lq * 4;
#pragma unroll
        for (int db = 0; db < 8; ++db) { u32x2 w; w.x = pk2(o[db][0] * inv, o[db][1] * inv); w.y = pk2(o[db][2] * inv, o[db][3] * inv); *(u32x2*)(op + db * 16) = w; }
    }
}

__device__ __forceinline__ void norm_phase(const Params& p) {
    const int lane = threadIdx.x & 63, gw = blockIdx.x * 8 + (threadIdx.x >> 6), nw = gridDim.x * 8;
    bf16_t* Y = (bf16_t*)(p.ws + OFF_Y); const bf16_t* Z = (const bf16_t*)(p.ws + OFF_Z); const float* nwt = p.in[12];
    for (int item = gw; item < MT * 8; item += nw) {
        const int row = item >> 3, g = item & 7; const size_t base = (size_t)row * SI + g * 512 + lane * 8;
        float y[8], z[8], wv[8];
        unpack8(*(const u32x4*)(Y + base), y); unpack8(*(const u32x4*)(Z + base), z); load8f(nwt + g * 512 + lane * 8, wv);
        float ss = 0.f;
#pragma unroll
        for (int k = 0; k < 8; ++k) { y[k] = y[k] * fsilu(z[k]); ss += y[k] * y[k]; }
#pragma unroll
        for (int off = 1; off < 64; off <<= 1) ss += __shfl_xor(ss, off, 64);
        const float rs = rsqrtf(ss * (1.0f / 512.0f) + 1e-5f);
        u32x4 w; w.x = pk2(y[0] * rs * wv[0], y[1] * rs * wv[1]); w.y = pk2(y[2] * rs * wv[2], y[3] * rs * wv[3]); w.z = pk2(y[4] * rs * wv[4], y[5] * rs * wv[5]); w.w = pk2(y[6] * rs * wv[6], y[7] * rs * wv[7]);
        *(u32x4*)(Y + base) = w;
    }
}

__device__ __forceinline__ void ln_phase(const float* src, const float* gam, const float* bet, float* dstf, bf16_t* dstb) {
    const int lane = threadIdx.x & 63, gw = blockIdx.x * 8 + (threadIdx.x >> 6), nw = gridDim.x * 8;
    for (int row = gw; row < MT; row += nw) {
        const float* s = src + (size_t)row * DM;
        f32x4 v[8]; float sum = 0.f;
#pragma unroll
        for (int k = 0; k < 8; ++k) { v[k] = *(const f32x4*)(s + (k * 64 + lane) * 4); sum += (v[k][0] + v[k][1]) + (v[k][2] + v[k][3]); }
#pragma unroll
        for (int off = 1; off < 64; off <<= 1) sum += __shfl_xor(sum, off, 64);
        const float mean = sum * (1.0f / 2048.0f);
        float q = 0.f;
#pragma unroll
        for (int k = 0; k < 8; ++k) { v[k] -= mean; q += (v[k][0] * v[k][0] + v[k][1] * v[k][1]) + (v[k][2] * v[k][2] + v[k][3] * v[k][3]); }
#pragma unroll
        for (int off = 1; off < 64; off <<= 1) q += __shfl_xor(q, off, 64);
        const float rs = rsqrtf(q * (1.0f / 2048.0f) + 1e-5f);
#pragma unroll
        for (int k = 0; k < 8; ++k) { const int c = (k * 64 + lane) * 4;
            const f32x4 o = v[k] * rs * *(const f32x4*)(gam + c) + *(const f32x4*)(bet + c);
            *(f32x4*)(dstf + (size_t)row * DM + c) = o;
            if (dstb) { u32x2 w; w.x = pk2(o[0], o[1]); w.y = pk2(o[2], o[3]); *(u32x2*)(dstb + (size_t)row * DM + c) = w; } }
    }
}

__global__ void __launch_bounds__(512, 2) mega(Params p) {
    const int lo = p.ph_lo, hi = p.ph_hi;
    PG8_LAS unsigned char* lds = (PG8_LAS unsigned char*)g_lds;
    const int G = gridDim.x, c = blockIdx.x;
    unsigned char* ws = p.ws;
#define IN(k) (lo <= (k) && (k) < hi)
#define SEAM(k) do { if (IN((k) + 1)) cg::this_grid().sync(); } while (0)
    if (IN(0)) { phase0(p); SEAM(0); }
    if (IN(1)) {
        pg8::Gemm g{(const bf16_t*)(ws + OFF_XB), (const bf16_t*)(ws + OFF_WIN), MT, NIN, DM}; pg8::StaticOrder S; S.init(MT, NIN, G, c);
        EpiIn E{(bf16_t*)(ws + OFF_Z), (bf16_t*)(ws + OFF_XBC), (bf16_t*)(ws + OFF_Q), (bf16_t*)(ws + OFF_KPB), (bf16_t*)(ws + OFF_VPB), (bf16_t*)(ws + OFF_KSB), (bf16_t*)(ws + OFF_VSB),
                (bf16_t*)(ws + OFF_GT), (float*)(ws + OFF_DT), p.out, p.in[9]};
        pg8::gemm_phase<EpiIn, pg8::StaticOrder>(lds, g, S, E);
        SEAM(1);
    }
    if (IN(2)) { conv_phase(p); SEAM(2); }
    if (IN(3)) { ssd_phase(p); attn_phase(p); SEAM(3); }
    if (IN(4)) {
        norm_phase(p);
        __syncthreads();
        tr_cvt<2>(p.in[19], 2 * DFF, DM, (bf16_t*)(ws + OFF_WGU), 2 * DFF);
        tr_cvt<0>(p.in[20], DM, DFF, (bf16_t*)(ws + OFF_WDN), DM);
        SEAM(4);
    }
    if (IN(5)) {
        { pg8::Gemm g{(const bf16_t*)(ws + OFF_Y), (const bf16_t*)(ws + OFF_WSSD), MT, DM, SI}; pg8::StaticOrder S; S.init(MT, DM, G, c);
          EpiSsdOut E{p.out + O_YP, (const bf16_t*)(ws + OFF_GT)};
          pg8::gemm_phase<EpiSsdOut, pg8::StaticOrder>(lds, g, S, E); }
        { pg8::Gemm g{(const bf16_t*)(ws + OFF_ATT), (const bf16_t*)(ws + OFF_WATT), MT, DM, DM}; pg8::StaticOrder S; S.init(MT, DM, G, c);
          EpiAttOut E{p.out + O_YP, (const bf16_t*)(ws + OFF_GT), (bf16_t*)(ws + OFF_MIXED)};
          pg8::gemm_phase<EpiAttOut, pg8::StaticOrder>(lds, g, S, E); }
        SEAM(5);
    }
    if (IN(6)) {
        pg8::Gemm g{(const bf16_t*)(ws + OFF_MIXED), (const bf16_t*)(ws + OFF_WO), MT, DM, DM}; pg8::StaticOrder S; S.init(MT, DM, G, c);
        EpiResid E{p.in[0], p.in[1], p.out + O_YP};
        pg8::gemm_phase<EpiResid, pg8::StaticOrder>(lds, g, S, E);
        SEAM(6);
    }
    if (IN(7)) { ln_phase(p.out + O_YP, p.in[17], p.in[18], (float*)(ws + OFF_H), (bf16_t*)(ws + OFF_HB)); SEAM(7); }
    if (IN(8)) {
        pg8::Gemm g{(const bf16_t*)(ws + OFF_HB), (const bf16_t*)(ws + OFF_WGU), MT, 2 * DFF, DM}; pg8::StaticOrder S; S.init(MT, 2 * DFF, G, c);
        EpiGateUp E{(bf16_t*)(ws + OFF_ACT)};
        pg8::gemm_phase<EpiGateUp, pg8::StaticOrder>(lds, g, S, E);
        SEAM(8);
    }
    if (IN(9)) {
        pg8::Gemm g{(const bf16_t*)(ws + OFF_ACT), (const bf16_t*)(ws + OFF_WDN), MT, DM, DFF}; pg8::StaticOrder S; S.init(MT, DM, G, c);
        EpiResid E{(const float*)(ws + OFF_H), (const float*)(ws + OFF_H) + (size_t)MP * DM, p.out + O_YP};
        pg8::gemm_phase<EpiResid, pg8::StaticOrder>(lds, g, S, E);
        SEAM(9);
    }
    if (IN(10)) { ln_phase(p.out + O_YP, p.in[21], p.in[22], p.out + O_YP, nullptr); }
#undef IN
#undef SEAM
}

extern "C" void kernel_launch(void* const* d_in, const int* in_sizes, int n_in, void* d_out, int out_size, void* d_ws, size_t ws_size, hipStream_t stream) {
    static int grid = 0;
    if (grid == 0) {
        if (n_in != 23 || ws_size < WS_END) { fprintf(stderr, "kernel_launch: unexpected n_in %d or ws_size %zu (< %zu)\n", n_in, ws_size, (size_t)WS_END); grid = -1; return; }
        int dev = 0, cus = 0, per_cu = 0;
        hipGetDevice(&dev); hipDeviceGetAttribute(&cus, hipDeviceAttributeMultiprocessorCount, dev);
        if (hipFuncSetAttribute((const void*)mega, hipFuncAttributeMaxDynamicSharedMemorySize, LDS_BYTES) != hipSuccess) { fprintf(stderr, "kernel_launch: hipFuncSetAttribute failed\n"); grid = -1; return; }
        if (hipOccupancyMaxActiveBlocksPerMultiprocessor(&per_cu, (const void*)mega, 512, LDS_BYTES) != hipSuccess || per_cu < 1) { fprintf(stderr, "kernel_launch: occupancy query gave %d\n", per_cu); (void)hipGetLastError(); grid = -1; return; }
        grid = cus;
    }
    if (grid < 0) return;
    Params p{};
    for (int i = 0; i < 23; ++i) p.in[i] = (const float*)d_in[i];
    p.out = (float*)d_out; p.ws = (unsigned char*)d_ws;
#if ONE_LAUNCH
    p.ph_lo = 0; p.ph_hi = NPH;
    void* args[] = {&p};
    hipError_t e = hipLaunchCooperativeKernel((const void*)mega, dim3(grid), dim3(512), args, LDS_BYTES, stream);
    if (e != hipSuccess) fprintf(stderr, "cooperative launch failed: %s (grid %d)\n", hipGetErrorString(e), grid);
#else
    for (int ph = 0; ph < NPH; ++ph) { p.ph_lo = ph; p.ph_hi = ph + 1; hipLaunchKernelGGL(mega, dim3(grid), dim3(512), LDS_BYTES, stream, p); }
#endif
}
```

```cpp
#include <hip/hip_runtime.h>
#include <hip/hip_cooperative_groups.h>
#include <cstdio>
namespace cg = cooperative_groups;

#ifndef ONE_LAUNCH
#define ONE_LAUNCH 1
#endif
#ifndef PROBE_REP
#define PROBE_REP -1
#endif
#define REPS(k) for (int rep_ = 0; rep_ < ((PROBE_REP) == (k) ? 2 : 1); ++rep_)

typedef unsigned short bf16_t;
typedef short bf16x8 __attribute__((ext_vector_type(8)));
typedef float f32x4 __attribute__((ext_vector_type(4)));
typedef unsigned u32x4 __attribute__((ext_vector_type(4)));
typedef unsigned u32x2 __attribute__((ext_vector_type(2)));

extern __shared__ __attribute__((aligned(16))) unsigned char g_lds[];

constexpr int MP = 8192, MS = 1024, MT = 9216, DM = 2048, SI = 4096, CD = 6144, DFF = 5632;
constexpr int NIN_SRC = 20544, NIN = 20736;
constexpr float ALPHA = 1.189207115002721f;
constexpr int NPH = 11;
constexpr int LDS_BYTES = 131072 + 512 + 16;
constexpr size_t O_YP = 0, O_CONVP = 18874368, O_SSMP = 18892800, O_KP = 19417088, O_VP = 20465664,
                 O_CONVS = 21514240, O_SSMS = 21809152, O_KS = 30197760, O_VS = 32294912;
constexpr size_t OFF_XB = 0, OFF_WIN = 37748736, OFF_XC = 0, OFF_ACT = 0;
constexpr size_t OFF_XBC = 122683392, OFF_Y = OFF_XBC, OFF_ATT = OFF_XBC + 75497472;
constexpr size_t OFF_Q = 235929600, OFF_KPB = 273678336, OFF_VPB = 307232768, OFF_KSB = 340787200, OFF_VSB = 378535936;
constexpr size_t OFF_WGU = OFF_Q, OFF_WDN = 282066944, OFF_MIXED = 305135616, OFF_HB = 342884352;
constexpr size_t OFF_Z = 416284672, OFF_H = OFF_Z, OFF_GT = 491782144, OFF_DT = 567279616;
constexpr size_t OFF_WSSD = 569638912, OFF_WATT = 586416128, OFF_WO = 594804736, OFF_CTL = 603193344, OFF_BAR = 603197440, WS_END = 603197440 + 16384;

struct Params { const float* in[23]; float* out; unsigned char* ws; int ph_lo, ph_hi; };

typedef __bf16 bf16x2_t __attribute__((ext_vector_type(2)));
typedef float f32x2_t __attribute__((ext_vector_type(2)));
__device__ __forceinline__ unsigned pk2(float lo, float hi) { const f32x2_t v = {lo, hi}; const bf16x2_t r = __builtin_convertvector(v, bf16x2_t); return __builtin_bit_cast(unsigned, r); }
__device__ __forceinline__ bf16_t f2bf(float f) { unsigned u = __float_as_uint(f); u += 0x7FFFu + ((u >> 16) & 1u); return (bf16_t)(u >> 16); }
__device__ __forceinline__ float bf2f(bf16_t b) { return __uint_as_float(((unsigned)b) << 16); }
__device__ __forceinline__ float lo2f(unsigned w) { return __uint_as_float(w << 16); }
__device__ __forceinline__ float hi2f(unsigned w) { return __uint_as_float(w & 0xffff0000u); }
__device__ __forceinline__ float fsig(float x) { return __builtin_amdgcn_rcpf(1.0f + __expf(-x)); }
__device__ __forceinline__ float fsilu(float x) { return x * fsig(x); }
__device__ __forceinline__ u32x4 cvt8(const float* s) {
    const f32x4 a = __builtin_nontemporal_load((const f32x4*)s), b = __builtin_nontemporal_load((const f32x4*)(s + 4));
    u32x4 r; r.x = pk2(a[0], a[1]); r.y = pk2(a[2], a[3]); r.z = pk2(b[0], b[1]); r.w = pk2(b[2], b[3]); return r;
}
__device__ __forceinline__ f32x4 mfma16(bf16x8 a, bf16x8 b, f32x4 c) { return __builtin_amdgcn_mfma_f32_16x16x32_bf16(a, b, c, 0, 0, 0); }

namespace pg8 {
#define PG8_LAS __attribute__((address_space(3)))
constexpr int BM = 256, BK = 64, HALF = 128, HTB = HALF * BK * 2, STAGE_BYTES = 8 * HTB, NXCD = 8, WGM = 8;
__host__ __device__ __forceinline__ int lds_byte(int r, int c) { const int st = (r >> 4) * 2 + (c >> 5), rr = r & 15, cc = c & 31, ob = rr * 64 + cc * 2; return st * 1024 + (ob ^ (((ob >> 9) & 1) << 5)); }
__host__ __device__ __forceinline__ void stage_rc(int b, int& R, int& C) { const int st = b / 1024, sb = b % 1024, swz = sb ^ (((sb >> 9) & 1) << 5); R = (st >> 1) * 16 + swz / 64; C = (st & 1) * 32 + (swz % 64) / 2; }
__host__ __device__ __forceinline__ int perm32(int rho) { const int n = rho >> 4, i = rho & 15; return 8 * (i >> 2) + 4 * n + (i & 3); }
struct Unit { int pm, pn, k0t, nkt, tau, sidx, nsp; };
struct Gemm { const bf16_t* A; const bf16_t* Bt; int M, N, K; };
struct TailOrder {
    int nM, nN, U, G, c, ntK, full, T, s, p5;
    __device__ __forceinline__ void init(int M, int N, int K, int G_, int c_, int p5_) {
        nM = M / BM; nN = N / BM; U = nM * nN; G = G_; c = c_; ntK = K / BK; full = U / G; T = U - full * G; p5 = p5_;
        const int smax = ntK / 4;
        { const int lim = T ? G / T : 1; s = 1; while (s * 2 <= lim && s * 2 <= smax && s * 2 <= 8) s *= 2; }
#ifdef NOSPLIT
        s = 1;
#endif
    }
    __device__ __forceinline__ void tile(int L, Unit& u) const {
        int wgid = L; { const int q = U / NXCD, r = U % NXCD, xcd = wgid % NXCD, off = wgid / NXCD; wgid = (xcd < r ? xcd * (q + 1) : r * (q + 1) + (xcd - r) * q) + off; }
        const int nig = WGM * nN, gid = wgid / nig, fm = gid * WGM, gsz = (nM - fm) < WGM ? (nM - fm) : WGM;
        u.pm = fm + ((wgid % nig) % gsz); u.pn = (wgid % nig) / gsz;
    }
    __device__ __forceinline__ void fill(PG8_LAS unsigned char* lds, int tid) const {
        PG8_LAS int* tab = (PG8_LAS int*)(lds + STAGE_BYTES);
        if (tid < 16) { Unit t; const bool ok = next_(tid, t); tab[tid * 8 + 0] = ok ? t.pm : -1; tab[tid * 8 + 1] = t.pn; tab[tid * 8 + 2] = t.k0t; tab[tid * 8 + 3] = t.nkt; tab[tid * 8 + 4] = t.tau; tab[tid * 8 + 5] = t.sidx; tab[tid * 8 + 6] = t.nsp; }
        __syncthreads();
    }
    __device__ __forceinline__ bool get(PG8_LAS unsigned char* lds, int i, Unit& u) const {
        const PG8_LAS int* tab = (const PG8_LAS int*)(lds + STAGE_BYTES) + i * 8;
        const int pm = __builtin_amdgcn_readfirstlane(tab[0]);
        u.pm = pm; u.pn = __builtin_amdgcn_readfirstlane(tab[1]); u.k0t = __builtin_amdgcn_readfirstlane(tab[2]); u.nkt = __builtin_amdgcn_readfirstlane(tab[3]);
        u.tau = __builtin_amdgcn_readfirstlane(tab[4]); u.sidx = __builtin_amdgcn_readfirstlane(tab[5]); u.nsp = __builtin_amdgcn_readfirstlane(tab[6]);
        return pm >= 0;
    }
    __device__ __forceinline__ bool next_(int i, Unit& u) const {
        u.pm = 0; u.pn = 0; u.k0t = 0; u.nkt = ntK; u.tau = 0; u.sidx = 0; u.nsp = 1;
        if (i < full) { tile(i * G + c, u); return true; }
        if (i == full && T > 0) {
            if (s == 1) { if (c >= T) return false; tile(full * G + c, u); return true; }
            if (c >= T * s) return false;
            const int tau = c % T, j = c / T; tile(full * G + tau, u); u.tau = tau; u.sidx = j; u.nsp = s;
            int k0p, np;
            { const int pairs = ntK / 2, base = pairs / s, rem = pairs % s; k0p = j * base + (j < rem ? j : rem); np = base + (j < rem ? 1 : 0); }
            u.k0t = 2 * k0p; u.nkt = 2 * np; return true;
        }
        return false;
    }
};

template <class Epi, class Sched>
__device__ __forceinline__ void gemm_phase(PG8_LAS unsigned char* lds, const Gemm g, const Sched& S, const Epi& E, float* part, unsigned* cnt) {
    int tid_ = threadIdx.x;
    const int tid = tid_, wid = __builtin_amdgcn_readfirstlane(tid >> 6), lane = tid & 63, wr = wid >> 2, wc = wid & 3, fr = lane & 15, fq = lane >> 4;
    S.fill(lds, tid);
    __builtin_amdgcn_sched_barrier(0);
    const int K = g.K;
    unsigned voffA[2], voffB[2];
#pragma unroll
    for (int i = 0; i < 2; ++i) { int R, C; stage_rc(tid * 16 + i * 8192, R, C); const int Rb = Epi::PERM ? ((R & ~31) + perm32(R & 31)) : R;
        voffA[i] = (unsigned)(R * K + C) * 2u; voffB[i] = (unsigned)(Rb * K + C) * 2u; }
    const size_t kstep = (size_t)(BK * 2);
    const size_t hstep = (size_t)HALF * K * 2;
    const size_t tstep = 2 * hstep;
    const unsigned ldsw = (unsigned)wid * 1024u;
    const int aoff = lds_byte(wr * 64 + fr, fq * 8), boff = lds_byte(wc * 32 + fr, fq * 8);
#define PG8_SA(b, h) (((b) * 2 + (h)) * HTB)
#define PG8_SB(b, h) ((4 + (b) * 2 + (h)) * HTB)
#define PG8_STAGE(bufoff, gbase, voff) do { _Pragma("unroll") for (int _i = 0; _i < 2; ++_i) \
        __builtin_amdgcn_global_load_lds((const unsigned*)((const char*)(gbase) + (voff)[_i]), (PG8_LAS unsigned*)(lds + (bufoff) + ldsw + _i * 8192), 16, 0, 0); } while (0)
#define PG8_LDA(dst, b, h) do { _Pragma("unroll") for (int m = 0; m < 4; ++m) _Pragma("unroll") for (int k = 0; k < 2; ++k) dst[m][k] = *(const PG8_LAS bf16x8*)(lds + PG8_SA(b, h) + aoff + m * 2048 + k * 1024); } while (0)
#define PG8_LDB(dst, b, h) do { _Pragma("unroll") for (int n = 0; n < 2; ++n) _Pragma("unroll") for (int k = 0; k < 2; ++k) dst[n][k] = *(const PG8_LAS bf16x8*)(lds + PG8_SB(b, h) + boff + n * 2048 + k * 1024); } while (0)
#define PG8_MMA(ai, bj, At, Bt) do { __builtin_amdgcn_s_setprio(1); _Pragma("unroll") for (int m = 0; m < 4; ++m) _Pragma("unroll") for (int n = 0; n < 2; ++n) _Pragma("unroll") for (int k = 0; k < 2; ++k) \
        acc[ai][bj][m][n] = __builtin_amdgcn_mfma_f32_16x16x32_bf16(Bt[n][k], At[m][k], acc[ai][bj][m][n], 0, 0, 0); __builtin_amdgcn_s_setprio(0); } while (0)
#define PG8_WAIT_V(n) asm volatile("s_waitcnt vmcnt(" #n ")" ::: "memory")
#define PG8_WAIT_L(n) asm volatile("s_waitcnt lgkmcnt(" #n ")" ::: "memory")
#define PG8_BAR __builtin_amdgcn_s_barrier()
#define PG8_SCHED __builtin_amdgcn_sched_barrier(0)
    Unit cur, nxt; int ui = 0;
    if (!S.get(lds, 0, cur)) return;
    f32x4 acc[2][2][4][2];
#pragma unroll
    for (int a = 0; a < 2; ++a)
#pragma unroll
        for (int b = 0; b < 2; ++b)
#pragma unroll
            for (int m = 0; m < 4; ++m)
#pragma unroll
                for (int n = 0; n < 2; ++n) acc[a][b][m][n] = (f32x4){0.f, 0.f, 0.f, 0.f};
    bf16x8 At[4][2], B0[2][2], B1[2][2];
    const char* cA = (const char*)g.A + (size_t)cur.pm * tstep + (size_t)cur.k0t * kstep; const char* cB = (const char*)g.Bt + (size_t)cur.pn * tstep + (size_t)cur.k0t * kstep;
    PG8_STAGE(PG8_SB(0, 0), cB, voffB); PG8_STAGE(PG8_SB(0, 1), cB + hstep, voffB); PG8_STAGE(PG8_SA(0, 0), cA, voffA); PG8_STAGE(PG8_SA(0, 1), cA + hstep, voffA);
    if (wr == 1) PG8_BAR;
    PG8_WAIT_V(2); PG8_BAR;
    PG8_STAGE(PG8_SB(1, 0), cB + kstep, voffB); PG8_STAGE(PG8_SA(1, 0), cA + kstep, voffA); PG8_STAGE(PG8_SB(1, 1), cB + hstep + kstep, voffB);
    PG8_WAIT_V(6); PG8_BAR;
    for (;;) {
        const bool has_next = S.get(lds, ui + 1, nxt);
        const char* nA = has_next ? (const char*)g.A + (size_t)nxt.pm * tstep + (size_t)nxt.k0t * kstep : cA; const char* nB = has_next ? (const char*)g.Bt + (size_t)nxt.pn * tstep + (size_t)nxt.k0t * kstep : cB;
        const int nt = cur.nkt;
        for (int t = 0; t < nt; t += 2) {
            const bool last = (t == nt - 2);
            const char* a1 = cA + (size_t)(t + 1) * kstep;
            const char* a2 = last ? nA : cA + (size_t)(t + 2) * kstep; const char* b2 = last ? nB : cB + (size_t)(t + 2) * kstep;
            const char* a3 = a2 + kstep; const char* b3 = b2 + kstep;
            PG8_LDB(B0, 0, 0); PG8_LDB(B1, 0, 1); PG8_SCHED; PG8_LDA(At, 0, 0); PG8_STAGE(PG8_SA(1, 1), a1 + hstep, voffA);
            PG8_WAIT_V(8); PG8_WAIT_L(0); PG8_BAR; PG8_MMA(0, 0, At, B0); PG8_MMA(0, 1, At, B1); PG8_BAR; PG8_SCHED;
            PG8_LDA(At, 0, 1); PG8_STAGE(PG8_SB(0, 0), b2, voffB); PG8_STAGE(PG8_SB(0, 1), b2 + hstep, voffB); PG8_STAGE(PG8_SA(0, 0), a2, voffA);
            PG8_WAIT_V(8); PG8_WAIT_L(0); PG8_BAR; PG8_MMA(1, 0, At, B0); PG8_MMA(1, 1, At, B1); PG8_BAR; PG8_SCHED;
            PG8_LDB(B0, 1, 0); PG8_LDB(B1, 1, 1); PG8_SCHED; PG8_LDA(At, 1, 0); PG8_STAGE(PG8_SA(0, 1), a2 + hstep, voffA);
            PG8_WAIT_V(8); PG8_WAIT_L(0); PG8_BAR; PG8_MMA(0, 0, At, B0); PG8_MMA(0, 1, At, B1); PG8_BAR; PG8_SCHED;
            PG8_LDA(At, 1, 1); PG8_STAGE(PG8_SB(1, 0), b3, voffB); PG8_STAGE(PG8_SB(1, 1), b3 + hstep, voffB); PG8_STAGE(PG8_SA(1, 0), a3, voffA);
            PG8_WAIT_V(8); PG8_WAIT_L(0); PG8_BAR; PG8_MMA(1, 0, At, B0); PG8_MMA(1, 1, At, B1); PG8_BAR; PG8_SCHED;
        }
        if (wr == 0) PG8_BAR;
        bool doit = true, reduced = false;
        if (!has_next) {
            PG8_WAIT_V(0);
            PG8_BAR;
            if (cur.nsp > 1) {
                {
                    float* q = part + (size_t)(cur.tau * cur.nsp + cur.sidx) * 65536 + tid * 4;
#pragma unroll
                    for (int a = 0; a < 2; ++a)
#pragma unroll
                        for (int b = 0; b < 2; ++b)
#pragma unroll
                            for (int m = 0; m < 4; ++m)
#pragma unroll
                                for (int n = 0; n < 2; ++n) { asm volatile("global_store_dwordx4 %0, %1, off sc1" :: "v"(q), "v"(acc[a][b][m][n]) : "memory"); q += 2048; asm volatile("" : "+v"(q)); }
                }
                asm volatile("s_waitcnt vmcnt(0)" ::: "memory");
                __syncthreads();
                if (tid == 0) {
                    __hip_atomic_fetch_add(cnt + cur.tau, 1u, __ATOMIC_RELAXED, __HIP_MEMORY_SCOPE_AGENT);
                    while (__hip_atomic_load(cnt + cur.tau, __ATOMIC_RELAXED, __HIP_MEMORY_SCOPE_AGENT) < (unsigned)cur.nsp) __builtin_amdgcn_s_sleep(4);
                }
                __syncthreads();
                const int np = 16 / cur.nsp;
                const float* qt = part + (size_t)(cur.tau * cur.nsp) * 65536 + tid * 4;
                for (int pi = 0; pi < np; ++pi) {
                    const int vp = cur.sidx * np + pi, a = vp >> 3, b = (vp >> 2) & 1, m = vp & 3;
                    f32x4 s0 = (f32x4){0.f, 0.f, 0.f, 0.f}, s1 = s0;
                    for (int j = 0; j < cur.nsp; ++j) {
                        const unsigned long long* q8 = (const unsigned long long*)(qt + (size_t)j * 65536 + (size_t)vp * 4096);
                        const unsigned long long w0 = __hip_atomic_load(q8, __ATOMIC_RELAXED, __HIP_MEMORY_SCOPE_AGENT), w1 = __hip_atomic_load(q8 + 1, __ATOMIC_RELAXED, __HIP_MEMORY_SCOPE_AGENT);
                        const unsigned long long w2 = __hip_atomic_load(q8 + 1024, __ATOMIC_RELAXED, __HIP_MEMORY_SCOPE_AGENT), w3 = __hip_atomic_load(q8 + 1025, __ATOMIC_RELAXED, __HIP_MEMORY_SCOPE_AGENT);
                        s0 += (f32x4){__uint_as_float((unsigned)w0), __uint_as_float((unsigned)(w0 >> 32)), __uint_as_float((unsigned)w1), __uint_as_float((unsigned)(w1 >> 32))};
                        s1 += (f32x4){__uint_as_float((unsigned)w2), __uint_as_float((unsigned)(w2 >> 32)), __uint_as_float((unsigned)w3), __uint_as_float((unsigned)(w3 >> 32))};
                    }
                    E.pair(cur, a, b, m, wr, wc, fr, fq, s0, s1);
                }
                doit = false;
            }
        }
        if (doit) E(acc, cur, wr, wc, fr, fq, reduced);
        if (!has_next) break;
#pragma unroll
        for (int a = 0; a < 2; ++a)
#pragma unroll
            for (int b = 0; b < 2; ++b)
#pragma unroll
                for (int m = 0; m < 4; ++m)
#pragma unroll
                    for (int n = 0; n < 2; ++n) acc[a][b][m][n] = (f32x4){0.f, 0.f, 0.f, 0.f};
        cur = nxt; cA = nA; cB = nB; ++ui;
        if (wr == 1) PG8_BAR;
    }
    __syncthreads();
#undef PG8_SA
#undef PG8_SB
#undef PG8_STAGE
#undef PG8_LDA
#undef PG8_LDB
#undef PG8_MMA
#undef PG8_WAIT_V
#undef PG8_WAIT_L
#undef PG8_BAR
#undef PG8_SCHED
}
}
using pg8::Unit;

__device__ __forceinline__ u32x4 pack8(const f32x4 a, const f32x4 b) { u32x4 w; w.x = pk2(a[0], a[1]); w.y = pk2(a[2], a[3]); w.z = pk2(b[0], b[1]); w.w = pk2(b[2], b[3]); return w; }

#define EPI_FULL_TILE() \
    __device__ __forceinline__ void operator()(const f32x4 (&acc)[2][2][4][2], const Unit& u, int wr, int wc, int fr, int fq, bool) const { \
        _Pragma("unroll") for (int ai = 0; ai < 2; ++ai) _Pragma("unroll") for (int m = 0; m < 4; ++m) _Pragma("unroll") for (int bj = 0; bj < 2; ++bj) \
            pair(u, ai, bj, m, wr, wc, fr, fq, acc[ai][bj][m][0], acc[ai][bj][m][1]); }

struct EpiIn {
    static constexpr bool PERM = true;
    unsigned char* ws; float* out; const float* dt_bias;
    __device__ __forceinline__ void pair(const Unit& u, int ai, int bj, int m, int wr, int wc, int fr, int fq, f32x4 v0, f32x4 v1) const {
        const int pn = u.pn;
        bf16_t* const Z = (bf16_t*)(ws + OFF_Z); bf16_t* const XBC = (bf16_t*)(ws + OFF_XBC); bf16_t* const Q = (bf16_t*)(ws + OFF_Q); bf16_t* const KP = (bf16_t*)(ws + OFF_KPB); bf16_t* const VP = (bf16_t*)(ws + OFF_VPB);
        bf16_t* const KS = (bf16_t*)(ws + OFF_KSB); bf16_t* const VS = (bf16_t*)(ws + OFF_VSB); bf16_t* const GT = (bf16_t*)(ws + OFF_GT); float* const DT = (float*)(ws + OFF_DT);
        const int row = u.pm * 256 + wr * 64 + fr + ai * 128 + m * 16, cloc = wc * 32 + 8 * fq + bj * 128;
        if (pn < 16) {
            *(u32x4*)(Z + (size_t)row * SI + pn * 256 + cloc) = pack8(v0, v1);
        } else if (pn < 40) {
            const int c = (pn - 16) * 256 + cloc;
            *(u32x4*)(XBC + (size_t)row * CD + c) = pack8(v0, v1);
            float* o = nullptr;
            if (row < MP) { if (row >= MP - 3) o = out + O_CONVP + (size_t)(row - (MP - 3)) * CD + c; }
            else { const int t = (row - MP) & 63, b = (row - MP) >> 6; if (t >= 61) o = out + O_CONVS + (size_t)(b * 3 + t - 61) * CD + c; }
            if (o) { *(f32x4*)o = v0; *(f32x4*)(o + 4) = v1; }
        } else if (pn < 48) {
            *(u32x4*)(Q + (size_t)row * DM + (pn - 40) * 256 + cloc) = pack8(v0, v1);
        } else if (pn < 64) {
            const bool isk = pn < 56;
            const int c = (pn - (isk ? 48 : 56)) * 256 + cloc;
            bf16_t* d; float* o = nullptr;
            if (row < MP) { d = (isk ? KP : VP) + (size_t)row * DM + c; if (row >= MP - 512) o = out + (isk ? O_KP : O_VP) + (size_t)(row - (MP - 512)) * DM + c; }
            else { const int t = (row - MP) & 63, b = (row - MP) >> 6; d = (isk ? KS : VS) + ((size_t)b * 576 + 512 + t) * DM + c; o = out + (isk ? O_KS : O_VS) + (size_t)(row - MP) * DM + c; }
            *(u32x4*)d = pack8(v0, v1);
            if (o) { *(f32x4*)o = v0; *(f32x4*)(o + 4) = v1; }
        } else if (pn < 80) {
#pragma unroll
            for (int j = 0; j < 4; ++j) { v0[j] = fsig(v0[j]); v1[j] = fsig(v1[j]); }
            *(u32x4*)(GT + (size_t)row * 4096 + (pn - 64) * 256 + cloc) = pack8(v0, v1);
        } else {
            if (cloc < 64) {
                const f32x4 b0 = *(const f32x4*)(dt_bias + cloc), b1 = *(const f32x4*)(dt_bias + cloc + 4);
#pragma unroll
                for (int j = 0; j < 4; ++j) { float a = v0[j] + b0[j]; v0[j] = a > 20.f ? a : log1pf(__expf(a)); float c2 = v1[j] + b1[j]; v1[j] = c2 > 20.f ? c2 : log1pf(__expf(c2)); }
                *(f32x4*)(DT + (size_t)row * 64 + cloc) = v0; *(f32x4*)(DT + (size_t)row * 64 + cloc + 4) = v1;
            }
        }
    }
    template <int R> __device__ __forceinline__ void body(const f32x4 (&acc)[2][2][4][2], const Unit& u, int wr, int wc, int fr, int fq, bf16_t* dst, unsigned pitch, unsigned cbase, bf16_t* dstS, float* oP, float* oS) const {
        const int rbase = u.pm * 256 + wr * 64 + fr; const unsigned cl = cbase + wc * 32 + 8 * fq;
#pragma unroll
        for (int ai = 0; ai < 2; ++ai)
#pragma unroll
            for (int m = 0; m < 4; ++m) {
                const int row = rbase + ai * 128 + m * 16;
#pragma unroll
                for (int bj = 0; bj < 2; ++bj) {
                    const unsigned c = cl + bj * 128;
                    f32x4 v0 = acc[ai][bj][m][0], v1 = acc[ai][bj][m][1];
                    if (R == 0) { *(u32x4*)(dst + ((unsigned)row * pitch + c)) = pack8(v0, v1); }
                    if (R == 1) {
                        *(u32x4*)(dst + ((unsigned)row * pitch + c)) = pack8(v0, v1);
                        float* o = nullptr;
                        if (row < MP) { if (row >= MP - 3) o = oP + ((unsigned)(row - (MP - 3)) * CD + c); }
                        else { const int t = (row - MP) & 63, b = (row - MP) >> 6; if (t >= 61) o = oS + ((unsigned)(b * 3 + t - 61) * CD + c); }
                        if (o) { *(f32x4*)o = v0; *(f32x4*)(o + 4) = v1; }
                    }
                    if (R == 2) {
                        if (row < MP) { *(u32x4*)(dst + ((unsigned)row * DM + c)) = pack8(v0, v1);
                            if (row >= MP - 512) { float* o = oP + ((unsigned)(row - (MP - 512)) * DM + c); *(f32x4*)o = v0; *(f32x4*)(o + 4) = v1; } }
                        else { const int t = (row - MP) & 63, b = (row - MP) >> 6;
                            *(u32x4*)(dstS + ((unsigned)(b * 576 + 512 + t) * DM + c)) = pack8(v0, v1);
                            float* o = oS + ((unsigned)(row - MP) * DM + c); *(f32x4*)o = v0; *(f32x4*)(o + 4) = v1; }
                    }
                    if (R == 3) {
#pragma unroll
                        for (int j = 0; j < 4; ++j) { v0[j] = fsig(v0[j]); v1[j] = fsig(v1[j]); }
                        *(u32x4*)(dst + ((unsigned)row * pitch + c)) = pack8(v0, v1);
                    }
                    if (R == 4) {
                        if (c < 64) {
                            const f32x4 b0 = *(const f32x4*)(dt_bias + c), b1 = *(const f32x4*)(dt_bias + c + 4);
#pragma unroll
                            for (int j = 0; j < 4; ++j) { float a = v0[j] + b0[j]; v0[j] = a > 20.f ? a : log1pf(__expf(a)); float c2 = v1[j] + b1[j]; v1[j] = c2 > 20.f ? c2 : log1pf(__expf(c2)); }
                            float* o = (float*)dst + ((unsigned)row * 64 + c); *(f32x4*)o = v0; *(f32x4*)(o + 4) = v1;
                        }
                    }
                }
            }
    }
    __device__ __forceinline__ void operator()(const f32x4 (&acc)[2][2][4][2], const Unit& u, int wr, int wc, int fr, int fq, bool) const {
        const int pn = u.pn;
        if (pn < 16) body<0>(acc, u, wr, wc, fr, fq, (bf16_t*)(ws + OFF_Z), SI, pn * 256, nullptr, nullptr, nullptr);
        else if (pn < 40) body<1>(acc, u, wr, wc, fr, fq, (bf16_t*)(ws + OFF_XBC), CD, (pn - 16) * 256, nullptr, out + O_CONVP, out + O_CONVS);
        else if (pn < 48) body<0>(acc, u, wr, wc, fr, fq, (bf16_t*)(ws + OFF_Q), DM, (pn - 40) * 256, nullptr, nullptr, nullptr);
        else if (pn < 56) body<2>(acc, u, wr, wc, fr, fq, (bf16_t*)(ws + OFF_KPB), DM, (pn - 48) * 256, (bf16_t*)(ws + OFF_KSB), out + O_KP, out + O_KS);
        else if (pn < 64) body<2>(acc, u, wr, wc, fr, fq, (bf16_t*)(ws + OFF_VPB), DM, (pn - 56) * 256, (bf16_t*)(ws + OFF_VSB), out + O_VP, out + O_VS);
        else if (pn < 80) body<3>(acc, u, wr, wc, fr, fq, (bf16_t*)(ws + OFF_GT), 4096, (pn - 64) * 256, nullptr, nullptr, nullptr);
        else body<4>(acc, u, wr, wc, fr, fq, (bf16_t*)(ws + OFF_DT), 64, 0, nullptr, nullptr, nullptr);
    }
};

__device__ __forceinline__ f32x4 gate4(const bf16_t* g) { const u32x2 w = *(const u32x2*)g; return (f32x4){lo2f(w.x), hi2f(w.x), lo2f(w.y), hi2f(w.y)}; }
struct EpiSsdOut {
    static constexpr bool PERM = false;
    float* mixp; const bf16_t* GT;
    __device__ __forceinline__ void pair(const Unit& u, int ai, int bj, int m, int wr, int wc, int fr, int fq, f32x4 v0, f32x4 v1) const {
        const int row = u.pm * 256 + wr * 64 + fr + ai * 128 + m * 16; const unsigned col = u.pn * 256 + wc * 32 + 4 * fq + bj * 128;
        *(f32x4*)(mixp + ((unsigned)row * DM + col)) = v0 * gate4(GT + ((unsigned)row * 4096 + col));
        *(f32x4*)(mixp + ((unsigned)row * DM + col + 16)) = v1 * gate4(GT + ((unsigned)row * 4096 + col + 16));
    }
    EPI_FULL_TILE()
};
struct EpiAttOut {
    static constexpr bool PERM = false;
    const float* mixp; const bf16_t* GT; bf16_t* MIXED;
    __device__ __forceinline__ void pair(const Unit& u, int ai, int bj, int m, int wr, int wc, int fr, int fq, f32x4 v0, f32x4 v1) const {
        const int row = u.pm * 256 + wr * 64 + fr + ai * 128 + m * 16; const unsigned col = u.pn * 256 + wc * 32 + 4 * fq + bj * 128;
        v0 = *(const f32x4*)(mixp + ((unsigned)row * DM + col)) + v0 * gate4(GT + ((unsigned)row * 4096 + 2048 + col));
        v1 = *(const f32x4*)(mixp + ((unsigned)row * DM + col + 16)) + v1 * gate4(GT + ((unsigned)row * 4096 + 2048 + col + 16));
        u32x2 w; w.x = pk2(v0[0], v0[1]); w.y = pk2(v0[2], v0[3]); *(u32x2*)(MIXED + ((unsigned)row * DM + col)) = w;
        w.x = pk2(v1[0], v1[1]); w.y = pk2(v1[2], v1[3]); *(u32x2*)(MIXED + ((unsigned)row * DM + col + 16)) = w;
    }
    EPI_FULL_TILE()
};
struct EpiResid {
    static constexpr bool PERM = false;
    const float* resP; const float* resS; float* dst;
    __device__ __forceinline__ void pair(const Unit& u, int ai, int bj, int m, int wr, int wc, int fr, int fq, f32x4 v0, f32x4 v1) const {
        const int row = u.pm * 256 + wr * 64 + fr + ai * 128 + m * 16; const unsigned col = u.pn * 256 + wc * 32 + 4 * fq + bj * 128;
        const float* rp = row < MP ? resP + (size_t)row * DM : resS + (size_t)(row - MP) * DM;
        *(f32x4*)(dst + ((unsigned)row * DM + col)) = v0 + *(const f32x4*)(rp + col) * ALPHA;
        *(f32x4*)(dst + ((unsigned)row * DM + col + 16)) = v1 + *(const f32x4*)(rp + col + 16) * ALPHA;
    }
    EPI_FULL_TILE()
};
struct EpiGateUp {
    static constexpr bool PERM = false;
    bf16_t* ACT;
    __device__ __forceinline__ void pair(const Unit& u, int ai, int bj, int m, int wr, int wc, int fr, int fq, f32x4 gt, f32x4 up) const {
        const int row = u.pm * 256 + wr * 64 + fr + ai * 128 + m * 16; const unsigned col = u.pn * 128 + wc * 16 + 4 * fq + bj * 64;
        u32x2 w; w.x = pk2(fsilu(gt[0]) * up[0], fsilu(gt[1]) * up[1]); w.y = pk2(fsilu(gt[2]) * up[2], fsilu(gt[3]) * up[3]);
        *(u32x2*)(ACT + ((unsigned)row * DFF + col)) = w;
    }
    EPI_FULL_TILE()
};

template <int MAP> __device__ __forceinline__ int srccol(int n) {
    if (MAP == 0) return n;
    if (MAP == 1) { if (n < 10240) return n; if (n < 20480) return n + 64; if (n < 20544) return n - 20480 + 10240; return -1; }
    const int pn = n >> 8, c = n & 255;
    return ((c & 16) ? DFF : 0) + 128 * pn + 64 * (c >> 7) + 16 * ((c >> 5) & 3) + (c & 15);
}
template <int MAP> __device__ __forceinline__ void tr_cvt(const float* __restrict__ src, int ldsrc, int K, bf16_t* __restrict__ dst, int Nd, int ldd = 0, int koff = 0) {
    if (ldd == 0) ldd = K;
    float* T = (float*)g_lds;
    const int tid = threadIdx.x, n4 = (tid & 15) * 4, kr = tid >> 4  , wn = tid >> 3  , k8 = (tid & 7) * 8;
    const int ntn = Nd / 64, ntiles = ntn * (K / 64);
    for (int tile = blockIdx.x; tile < ntiles; tile += gridDim.x) {
        const int n0 = (tile % ntn) * 64, k0 = (tile / ntn) * 64;
        const int sc = srccol<MAP>(n0 + n4);
#pragma unroll
        for (int h = 0; h < 2; ++h) {
            const int kk = kr + 32 * h;
            const f32x4 v = sc >= 0 ? __builtin_nontemporal_load((const f32x4*)(src + (size_t)(k0 + kk) * ldsrc + sc)) : (f32x4){0.f, 0.f, 0.f, 0.f};
            T[kk * 65 + n4 + 0] = v[0]; T[kk * 65 + n4 + 1] = v[1]; T[kk * 65 + n4 + 2] = v[2]; T[kk * 65 + n4 + 3] = v[3];
        }
        __syncthreads();
        u32x4 w;
        w.x = pk2(T[(k8 + 0) * 65 + wn], T[(k8 + 1) * 65 + wn]); w.y = pk2(T[(k8 + 2) * 65 + wn], T[(k8 + 3) * 65 + wn]);
        w.z = pk2(T[(k8 + 4) * 65 + wn], T[(k8 + 5) * 65 + wn]); w.w = pk2(T[(k8 + 6) * 65 + wn], T[(k8 + 7) * 65 + wn]);
        *(u32x4*)(dst + (size_t)(n0 + wn) * ldd + koff + k0 + k8) = w;
        __syncthreads();
    }
}

__device__ __forceinline__ void phase0(const Params& p) {
    const size_t gt = (size_t)blockIdx.x * 512 + threadIdx.x, gs = (size_t)gridDim.x * 512;
    bf16_t* __restrict__ XB = (bf16_t*)(p.ws + OFF_XB);
#pragma unroll 4
    for (size_t i = gt; i < (size_t)MT * 256; i += gs) {
        const size_t row = i >> 8; const int c8 = (int)(i & 255) * 8;
        const float* s = row < MP ? p.in[0] + row * DM + c8 : p.in[1] + (row - MP) * DM + c8;
        *(u32x4*)(XB + row * DM + c8) = cvt8(s);
    }
    tr_cvt<1>(p.in[6], NIN_SRC, DM, (bf16_t*)(p.ws + OFF_WIN), NIN);
    tr_cvt<0>(p.in[14], DM, SI, (bf16_t*)(p.ws + OFF_WSSD), DM);
    tr_cvt<0>(p.in[15], DM, DM, (bf16_t*)(p.ws + OFF_WATT), DM);
    if (blockIdx.x == 0) for (int i = threadIdx.x; i < 1024; i += 512) ((unsigned*)(p.ws + OFF_CTL))[i] = 0u;
    tr_cvt<0>(p.in[16], DM, DM, (bf16_t*)(p.ws + OFF_WO), DM);
}

__device__ __forceinline__ void unpack8(const u32x4 v, float (&f)[8]) { f[0] = lo2f(v.x); f[1] = hi2f(v.x); f[2] = lo2f(v.y); f[3] = hi2f(v.y); f[4] = lo2f(v.z); f[5] = hi2f(v.z); f[6] = lo2f(v.w); f[7] = hi2f(v.w); }
__device__ __forceinline__ void load8f(const float* s, float (&f)[8]) { const f32x4 a = *(const f32x4*)s, b = *(const f32x4*)(s + 4); f[0] = a[0]; f[1] = a[1]; f[2] = a[2]; f[3] = a[3]; f[4] = b[0]; f[5] = b[1]; f[6] = b[2]; f[7] = b[3]; }
__device__ __forceinline__ void conv_phase(const Params& p) {
    const size_t gt = (size_t)blockIdx.x * 512 + threadIdx.x, gs = (size_t)gridDim.x * 512;
    const bf16_t* __restrict__ XBC = (const bf16_t*)(p.ws + OFF_XBC); bf16_t* __restrict__ XC = (bf16_t*)(p.ws + OFF_XC);
    const float* cw = p.in[7]; const float* cb = p.in[8]; const float* sc = p.in[4];
    for (size_t it = gt; it < (size_t)576 * 768; it += gs) {
        const int cgi = (int)(it % 768), rb = (int)(it / 768), c = cgi * 8, r0 = rb * 16;
        float w0[8], w1[8], w2[8], w3[8], bb[8], h0[8], h1[8], h2[8];
        load8f(cw + c, w0); load8f(cw + CD + c, w1); load8f(cw + 2 * CD + c, w2); load8f(cw + 3 * CD + c, w3); load8f(cb + c, bb);
        const bool sstart = (r0 >= MP) && (((r0 - MP) & 63) == 0);
        if (r0 == 0) {
#pragma unroll
            for (int k = 0; k < 8; ++k) { h0[k] = 0.f; h1[k] = 0.f; h2[k] = 0.f; }
        } else if (sstart) {
            const int b = (r0 - MP) >> 6;
            load8f(sc + (size_t)(b * 3 + 0) * CD + c, h0); load8f(sc + (size_t)(b * 3 + 1) * CD + c, h1); load8f(sc + (size_t)(b * 3 + 2) * CD + c, h2);
        } else {
            unpack8(*(const u32x4*)(XBC + (size_t)(r0 - 3) * CD + c), h0); unpack8(*(const u32x4*)(XBC + (size_t)(r0 - 2) * CD + c), h1); unpack8(*(const u32x4*)(XBC + (size_t)(r0 - 1) * CD + c), h2);
        }
#pragma unroll 4
        for (int rr = 0; rr < 16; ++rr) {
            float cur[8], o[8];
            unpack8(__builtin_nontemporal_load((const u32x4*)(XBC + (size_t)(r0 + rr) * CD + c)), cur);
#pragma unroll
            for (int k = 0; k < 8; ++k) { o[k] = fsilu(bb[k] + h0[k] * w0[k] + h1[k] * w1[k] + h2[k] * w2[k] + cur[k] * w3[k]); h0[k] = h1[k]; h1[k] = h2[k]; h2[k] = cur[k]; }
            u32x4 w; w.x = pk2(o[0], o[1]); w.y = pk2(o[2], o[3]); w.z = pk2(o[4], o[5]); w.w = pk2(o[6], o[7]);
            *(u32x4*)(XC + (size_t)(r0 + rr) * CD + c) = w;
        }
    }
}

struct SsdRegs { u32x4 rb0, rb1, rc0, rc1, rx; float rdt; };
struct SsdCtx { const bf16_t* XC; const float* DT; bf16_t* Y; const float* st_in; float* out; int head, pq, g; float a_h, dskip; };
__device__ __forceinline__ void ssd_load(SsdRegs& r, const SsdCtx& c, int s, int tid) {
    const size_t R0 = (size_t)s * 64; const int lane = tid & 63, w = tid >> 6;
    { const int v = tid, j = v >> 4, n8 = (v & 15) * 8; r.rb0 = *(const u32x4*)(c.XC + (R0 + j) * CD + 4096 + c.g * 128 + n8); r.rc0 = *(const u32x4*)(c.XC + (R0 + j) * CD + 5120 + c.g * 128 + n8); }
    { const int v = tid + 512, j = v >> 4, n8 = (v & 15) * 8; r.rb1 = *(const u32x4*)(c.XC + (R0 + j) * CD + 4096 + c.g * 128 + n8); r.rc1 = *(const u32x4*)(c.XC + (R0 + j) * CD + 5120 + c.g * 128 + n8); }
    if (tid < 128) r.rx = *(const u32x4*)(c.XC + (R0 + (tid >> 1)) * CD + c.head * 64 + c.pq * 16 + (tid & 1) * 8);
    if (w == 7) r.rdt = c.DT[(R0 + lane) * 64 + c.head];
}
__device__ __forceinline__ void ssd_stage(const SsdRegs& r, int b, int tid) {
    bf16_t* Bn = (bf16_t*)(g_lds + b * 17408); bf16_t* Cn = (bf16_t*)(g_lds + 34816 + b * 17408); bf16_t* Xt = (bf16_t*)(g_lds + 69632 + b * 2304);
    { const int v = tid, j = v >> 4, n8 = (v & 15) * 8; *(u32x4*)(Bn + j * 136 + n8) = r.rb0; *(u32x4*)(Cn + j * 136 + n8) = r.rc0; }
    { const int v = tid + 512, j = v >> 4, n8 = (v & 15) * 8; *(u32x4*)(Bn + j * 136 + n8) = r.rb1; *(u32x4*)(Cn + j * 136 + n8) = r.rc1; }
    if (tid < 128) { const int j = tid >> 1, p8 = (tid & 1) * 8; const u32x4 rx = r.rx;
        Xt[(p8 + 0) * 72 + j] = (bf16_t)(rx.x & 0xffff); Xt[(p8 + 1) * 72 + j] = (bf16_t)(rx.x >> 16);
        Xt[(p8 + 2) * 72 + j] = (bf16_t)(rx.y & 0xffff); Xt[(p8 + 3) * 72 + j] = (bf16_t)(rx.y >> 16);
        Xt[(p8 + 4) * 72 + j] = (bf16_t)(rx.z & 0xffff); Xt[(p8 + 5) * 72 + j] = (bf16_t)(rx.z >> 16);
        Xt[(p8 + 6) * 72 + j] = (bf16_t)(rx.w & 0xffff); Xt[(p8 + 7) * 72 + j] = (bf16_t)(rx.w >> 16); }
}
__device__ __forceinline__ void ssd_scan(int b, float dt, float a_h, int lane) {
    float* f = (float*)(g_lds + 94464 + b * 1280); float x = dt * a_h;
    x += __builtin_bit_cast(float, __builtin_amdgcn_update_dpp(0, __builtin_bit_cast(int, x), 0x111, 0xf, 0xf, true));
    x += __builtin_bit_cast(float, __builtin_amdgcn_update_dpp(0, __builtin_bit_cast(int, x), 0x112, 0xf, 0xf, true));
    x += __builtin_bit_cast(float, __builtin_amdgcn_update_dpp(0, __builtin_bit_cast(int, x), 0x114, 0xf, 0xf, true));
    x += __builtin_bit_cast(float, __builtin_amdgcn_update_dpp(0, __builtin_bit_cast(int, x), 0x118, 0xf, 0xf, true));
    { const float t0 = __builtin_bit_cast(float, __builtin_amdgcn_readlane(__builtin_bit_cast(int, x), 15)), t1 = __builtin_bit_cast(float, __builtin_amdgcn_readlane(__builtin_bit_cast(int, x), 31)),
                  t2 = __builtin_bit_cast(float, __builtin_amdgcn_readlane(__builtin_bit_cast(int, x), 47));
      x += (lane >= 48) ? (t0 + t1) + t2 : (lane >= 32) ? t0 + t1 : (lane >= 16) ? t0 : 0.f; }
    const float last = __builtin_bit_cast(float, __builtin_amdgcn_readlane(__builtin_bit_cast(int, x), 63));
    f[lane] = x; f[64 + lane] = dt; f[128 + lane] = __expf(last - x) * dt; f[192 + lane] = __expf(x);
    if (lane == 63) f[256] = __expf(x);
}
__device__ __forceinline__ void ssd_step(int s, SsdRegs& r, const SsdCtx& c, f32x4 (&hacc)[2], f32x4 (&h0r)[2], int tid, const int V) {
    const int lane = tid & 63, w = tid >> 6, l15 = lane & 15, lq = lane >> 4;
    bf16_t* Xw = (bf16_t*)(g_lds + 74240); bf16_t* Mm = (bf16_t*)(g_lds + 76544);
    const size_t R0 = (size_t)s * 64; const int b = s & 1;
    const bf16_t* Bn = (const bf16_t*)(g_lds + b * 17408); const bf16_t* Cn = (const bf16_t*)(g_lds + 34816 + b * 17408); const bf16_t* Xt = (const bf16_t*)(g_lds + 69632 + b * 2304);
    const bf16_t* Hh = (const bf16_t*)(g_lds + 85760 + b * 4352); bf16_t* Hn = (bf16_t*)(g_lds + 85760 + (b ^ 1) * 4352);
    const float* fcs = (const float*)(g_lds + 94464 + b * 1280); const float* fdt = fcs + 64; const float* fwj = fcs + 128; const float* fec = fcs + 192;
    float rdt_scan = 0.f;
    if (s + 1 < 144) { ssd_stage(r, b ^ 1, tid); rdt_scan = r.rdt; }
    if (!(V & 1)) { if (s + 3 < 144) ssd_load(r, c, s + 3, tid); }
    if (w >= 4 && s + 1 >= 128 && s + 1 < 144) {
        const float* src = c.st_in + (((size_t)(s + 1 - 128) * 64 + c.head) * 64 + c.pq * 16) * 128;
#pragma unroll
        for (int tt = 0; tt < 2; ++tt) h0r[tt] = *(const f32x4*)(src + l15 * 128 + ((w - 4) * 2 + tt) * 16 + lq * 4);
    }
    if (!(V & 4)) {
        const int it = w >> 1;
#pragma unroll
        for (int tj = 0; tj < 2; ++tj) {
            const int jt = (w & 1) * 2 + tj;
            f32x4 acc = (f32x4){0.f, 0.f, 0.f, 0.f};
#pragma unroll
            for (int nk = 0; nk < 4; ++nk) {
                const bf16x8 A = *(const bf16x8*)(Cn + (it * 16 + l15) * 136 + nk * 32 + lq * 8);
                const bf16x8 B = *(const bf16x8*)(Bn + (jt * 16 + l15) * 136 + nk * 32 + lq * 8);
                acc = mfma16(B, A, acc);
            }
            const int i = it * 16 + l15, j0 = jt * 16 + lq * 4;
            const float csi = fcs[i]; const f32x4 csj = *(const f32x4*)(fcs + j0), dtj = *(const f32x4*)(fdt + j0);
            float v[4];
#pragma unroll
            for (int e = 0; e < 4; ++e) v[e] = (j0 + e <= i) ? acc[e] * __expf(csi - csj[e]) * dtj[e] : 0.f;
            u32x2 wv; wv.x = pk2(v[0], v[1]); wv.y = pk2(v[2], v[3]);
            *(u32x2*)(Mm + i * 72 + j0) = wv;
        }
        if (tid < 256) { const int pp = tid >> 4, j4 = (tid & 15) * 4; const u32x2 xv = *(const u32x2*)(Xt + pp * 72 + j4); const f32x4 wj = *(const f32x4*)(fwj + j4);
            u32x2 o; o.x = pk2(lo2f(xv.x) * wj[0], hi2f(xv.x) * wj[1]); o.y = pk2(lo2f(xv.y) * wj[2], hi2f(xv.y) * wj[3]); *(u32x2*)(Xw + pp * 72 + j4) = o; }
    }
    __syncthreads();
    if (V & 8) { if (w == 7 && s + 1 < 144) ssd_scan(b ^ 1, rdt_scan, c.a_h, lane); }
    else if (w < 4) {
        const int it = w;
        f32x4 accd = (f32x4){0.f, 0.f, 0.f, 0.f}, acco = accd;
#pragma unroll
        for (int jk = 0; jk < 2; ++jk) {
            const bf16x8 A = *(const bf16x8*)(Mm + (it * 16 + l15) * 72 + jk * 32 + lq * 8);
            const bf16x8 B = *(const bf16x8*)(Xt + l15 * 72 + jk * 32 + lq * 8);
            accd = mfma16(B, A, accd);
        }
#pragma unroll
        for (int nk = 0; nk < 4; ++nk) {
            const bf16x8 A = *(const bf16x8*)(Cn + (it * 16 + l15) * 136 + nk * 32 + lq * 8);
            const bf16x8 B = *(const bf16x8*)(Hh + l15 * 136 + nk * 32 + lq * 8);
            acco = mfma16(B, A, acco);
        }
        { const int i = it * 16 + l15; const float ec = fec[i]; float yv[4];
#pragma unroll
          for (int e = 0; e < 4; ++e) yv[e] = accd[e] + ec * acco[e] + c.dskip * bf2f(Xt[(lq * 4 + e) * 72 + i]);
          u32x2 wv; wv.x = pk2(yv[0], yv[1]); wv.y = pk2(yv[2], yv[3]);
          *(u32x2*)(c.Y + (R0 + i) * SI + c.head * 64 + c.pq * 16 + lq * 4) = wv; }
    } else {
        const float cdec = fcs[256];
        u32x2 fr[8];
        { const unsigned a0 = (unsigned)(size_t)Bn + (unsigned)(((lq * 8 + (l15 >> 2)) * 136 + (w - 4) * 32 + 4 * (l15 & 3)) * 2);
          asm volatile("ds_read_b64_tr_b16 %0, %8\n\tds_read_b64_tr_b16 %1, %8 offset:1088\n\tds_read_b64_tr_b16 %2, %8 offset:8704\n\tds_read_b64_tr_b16 %3, %8 offset:9792\n\t"
                       "ds_read_b64_tr_b16 %4, %8 offset:32\n\tds_read_b64_tr_b16 %5, %8 offset:1120\n\tds_read_b64_tr_b16 %6, %8 offset:8736\n\tds_read_b64_tr_b16 %7, %8 offset:9824\n\ts_waitcnt lgkmcnt(0)"
                       : "=&v"(fr[0]), "=&v"(fr[1]), "=&v"(fr[2]), "=&v"(fr[3]), "=&v"(fr[4]), "=&v"(fr[5]), "=&v"(fr[6]), "=&v"(fr[7]) : "v"(a0) : "memory"); }
#pragma unroll
        for (int tt = 0; tt < 2; ++tt) {
            hacc[tt] *= cdec;
#pragma unroll
            for (int jk = 0; jk < 2; ++jk) {
                const bf16x8 A = *(const bf16x8*)(Xw + l15 * 72 + jk * 32 + lq * 8);
                u32x4 wv; wv.x = fr[tt * 4 + jk * 2].x; wv.y = fr[tt * 4 + jk * 2].y; wv.z = fr[tt * 4 + jk * 2 + 1].x; wv.w = fr[tt * 4 + jk * 2 + 1].y;
                hacc[tt] = mfma16(__builtin_bit_cast(bf16x8, wv), A, hacc[tt]);
            }
        }
        if (s >= 127) {
            float* dst = (s == 127) ? c.out + O_SSMP + ((size_t)c.head * 64 + c.pq * 16) * 128
                                    : c.out + O_SSMS + (((size_t)(s - 128) * 64 + c.head) * 64 + c.pq * 16) * 128;
#pragma unroll
            for (int tt = 0; tt < 2; ++tt) *(f32x4*)(dst + l15 * 128 + ((w - 4) * 2 + tt) * 16 + lq * 4) = hacc[tt];
            if (s + 1 < 144) { hacc[0] = h0r[0]; hacc[1] = h0r[1]; }
        }
#pragma unroll
        for (int tt = 0; tt < 2; ++tt) { u32x2 wv; wv.x = pk2(hacc[tt][0], hacc[tt][1]); wv.y = pk2(hacc[tt][2], hacc[tt][3]);
            *(u32x2*)(Hn + l15 * 136 + ((w - 4) * 2 + tt) * 16 + lq * 4) = wv; }
        if (!(V & 16)) { if (w == 7 && s + 1 < 144) ssd_scan(b ^ 1, rdt_scan, c.a_h, lane); }
    }
    __syncthreads();
}
__device__ __forceinline__ void ssd_phase(const Params& p, const int V) {
    const int tid = threadIdx.x, lane = tid & 63, w = tid >> 6, l15 = lane & 15, lq = lane >> 4;
    for (int item = blockIdx.x; item < 256; item += gridDim.x) {
        SsdCtx c; c.XC = (const bf16_t*)(p.ws + OFF_XC); c.DT = (const float*)(p.ws + OFF_DT); c.Y = (bf16_t*)(p.ws + OFF_Y); c.st_in = p.in[5]; c.out = p.out;
        c.head = item >> 2; c.pq = item & 3; c.g = c.head >> 3; c.a_h = -__expf(p.in[10][c.head]); c.dskip = p.in[11][c.head];
        SsdRegs r0, r1;
        r0.rx = (u32x4){0u, 0u, 0u, 0u}; r1.rx = r0.rx; r0.rdt = 0.f; r1.rdt = 0.f;
        f32x4 hacc[2], h0r[2]; hacc[0] = (f32x4){0.f, 0.f, 0.f, 0.f}; hacc[1] = hacc[0]; h0r[0] = hacc[0]; h0r[1] = hacc[0];
        __syncthreads();
        ssd_load(r0, c, 0, tid);
        ssd_load(r1, c, 1, tid);
        ssd_stage(r0, 0, tid);
        if (w == 7) ssd_scan(0, r0.rdt, c.a_h, lane);
        if (w >= 4) { bf16_t* Hh = (bf16_t*)(g_lds + 85760);
#pragma unroll
            for (int tt = 0; tt < 2; ++tt)
#pragma unroll
                for (int e = 0; e < 4; ++e) Hh[(lq * 4 + e) * 136 + ((w - 4) * 2 + tt) * 16 + l15] = 0; }
        ssd_load(r0, c, 2, tid);
        __syncthreads();
        for (int s = 0; s < 144; s += 2) {
            ssd_step(s, r1, c, hacc, h0r, tid, V);
            ssd_step(s + 1, r0, c, hacc, h0r, tid, V);
        }
    }
}

__device__ __forceinline__ int vt_addr(int d, int key) { return d * 64 + ((((key >> 2) ^ (d ^ (d >> 3))) & 15) << 2) + (key & 3); }
__device__ __forceinline__ void attn_phase(const Params& p) {
    int tid_ = threadIdx.x;
    const int tid = tid_, hw = tid >> 8, ht = tid & 255, lane = tid & 63, wq = (tid >> 6) & 3, l15 = lane & 15, lq = lane >> 4;
    unsigned char* hb = g_lds + hw * 36992;
    bf16_t* Ks = (bf16_t*)hb;
    bf16_t* Vs = (bf16_t*)(hb + 17408);
    float* bs = (float*)(hb + 34816);
    const bf16_t* Qg = (const bf16_t*)(p.ws + OFF_Q);
    bf16_t* ATT = (bf16_t*)(p.ws + OFF_ATT);
    const float scale = 0.08838834764831845f;
    for (int pi = blockIdx.x; pi < 1152; pi += gridDim.x) {
        const int u = pi * 2 + hw, head = u & 15;
        int qrow0, krow0; const bf16_t* Kg; const bf16_t* Vg; const float* Kf = nullptr; const float* Vf = nullptr;
        if (u < 2048) { const int n = u >> 4; qrow0 = n * 64; krow0 = n * 64 - 512; Kg = (const bf16_t*)(p.ws + OFF_KPB); Vg = (const bf16_t*)(p.ws + OFF_VPB); }
        else { const int b = (u - 2048) >> 4; qrow0 = MP + b * 64; krow0 = 0; Kg = (const bf16_t*)(p.ws + OFF_KSB) + (size_t)b * 576 * DM; Vg = (const bf16_t*)(p.ws + OFF_VSB) + (size_t)b * 576 * DM;
               Kf = p.in[2] + (size_t)b * 512 * DM; Vf = p.in[3] + (size_t)b * 512 * DM; }
        __syncthreads();
        for (int i = ht; i < 257; i += 256) bs[i] = p.in[13][head * 257 + i];
        bf16x8 Qf[4];
        { const bf16_t* qp = Qg + (size_t)(qrow0 + wq * 16 + l15) * DM + head * 128 + lq * 8;
#pragma unroll
          for (int ks = 0; ks < 4; ++ks) Qf[ks] = *(const bf16x8*)(qp + ks * 32); }
        float mrun = -INFINITY, lrun = 0.f;
        f32x4 o[8];
#pragma unroll
        for (int db = 0; db < 8; ++db) o[db] = (f32x4){0.f, 0.f, 0.f, 0.f};
        f32x4 raw[16];
#define ATT_LOAD(t_) do { const int kr_ = krow0 + (t_) * 64; if (kr_ >= 0) { \
            if (Kf != nullptr && (t_) < 8) { \
                _Pragma("unroll") for (int e = 0; e < 4; ++e) { const int v = ht + 256 * e; const size_t o_ = (size_t)(kr_ + (v >> 4)) * DM + head * 128 + (v & 15) * 8; \
                    raw[2 * e] = *(const f32x4*)(Kf + o_); raw[2 * e + 1] = *(const f32x4*)(Kf + o_ + 4); raw[8 + 2 * e] = *(const f32x4*)(Vf + o_); raw[9 + 2 * e] = *(const f32x4*)(Vf + o_ + 4); } \
            } else { \
                _Pragma("unroll") for (int e = 0; e < 4; ++e) { const int v = ht + 256 * e; const size_t o_ = (size_t)(kr_ + (v >> 4)) * DM + head * 128 + (v & 15) * 8; \
                    raw[e] = *(const f32x4*)(Kg + o_); raw[4 + e] = *(const f32x4*)(Vg + o_); } \
            } } } while (0)
        ATT_LOAD(8);
        for (int itl = 0; itl < 9; ++itl) {
            const int t = itl == 0 ? 8 : itl - 1;
            const bool valid = (krow0 + t * 64) >= 0;
            __syncthreads();
            if (valid) {
                u32x4 rk[4], rv[4];
                if (Kf != nullptr && t < 8) {
#pragma unroll
                    for (int e = 0; e < 4; ++e) { rk[e] = pack8(raw[2 * e], raw[2 * e + 1]); rv[e] = pack8(raw[8 + 2 * e], raw[9 + 2 * e]); }
                } else {
#pragma unroll
                    for (int e = 0; e < 4; ++e) { rk[e] = __builtin_bit_cast(u32x4, raw[e]); rv[e] = __builtin_bit_cast(u32x4, raw[4 + e]); }
                }
#pragma unroll
                for (int e = 0; e < 4; ++e) { const int v = ht + 256 * e; *(u32x4*)(Ks + (v >> 4) * 136 + (v & 15) * 8) = rk[e]; }
#pragma unroll
                for (int e = 0; e < 4; ++e) { const int v = ht + 256 * e; *(u32x4*)(Vs + (v >> 4) * 136 + (v & 15) * 8) = rv[e]; }
            }
            __syncthreads();
            if (itl + 1 < 9) ATT_LOAD(itl);
            if (valid) {
                f32x4 sc[4];
#pragma unroll
                for (int kt = 0; kt < 4; ++kt) { sc[kt] = (f32x4){0.f, 0.f, 0.f, 0.f};
#pragma unroll
                    for (int ks = 0; ks < 4; ++ks) { const bf16x8 A = *(const bf16x8*)(Ks + (kt * 16 + l15) * 136 + ks * 32 + lq * 8); sc[kt] = mfma16(A, Qf[ks], sc[kt]); } }
                const int qi = wq * 16 + l15;
                float tmax = -INFINITY;
#pragma unroll
                for (int kt = 0; kt < 4; ++kt)
#pragma unroll
                    for (int e = 0; e < 4; ++e) { const int j = t * 64 + kt * 16 + lq * 4 + e; int rel = qi - j + 512; rel = rel < -128 ? -128 : (rel > 128 ? 128 : rel);
                        const float sv = sc[kt][e] * scale + bs[rel + 128]; sc[kt][e] = sv; tmax = fmaxf(tmax, sv); }
                tmax = fmaxf(tmax, __shfl_xor(tmax, 16, 64)); tmax = fmaxf(tmax, __shfl_xor(tmax, 32, 64));
                const float mnew = fmaxf(mrun, tmax), alpha = __expf(mrun - mnew);
                float psum = 0.f;
#pragma unroll
                for (int kt = 0; kt < 4; ++kt)
#pragma unroll
                    for (int e = 0; e < 4; ++e) { const float pv = __expf(sc[kt][e] - mnew); sc[kt][e] = pv; psum += pv; }
                psum += __shfl_xor(psum, 16, 64); psum += __shfl_xor(psum, 32, 64);
                lrun = lrun * alpha + psum; mrun = mnew;
#pragma unroll
                for (int db = 0; db < 8; ++db) o[db] *= alpha;
                bf16x8 Bp[2];
#pragma unroll
                for (int k2 = 0; k2 < 2; ++k2) { u32x4 w; w.x = pk2(sc[2 * k2][0], sc[2 * k2][1]); w.y = pk2(sc[2 * k2][2], sc[2 * k2][3]); w.z = pk2(sc[2 * k2 + 1][0], sc[2 * k2 + 1][1]); w.w = pk2(sc[2 * k2 + 1][2], sc[2 * k2 + 1][3]);
                    Bp[k2] = __builtin_bit_cast(bf16x8, w); }
                { const unsigned va = (unsigned)(size_t)Vs + (unsigned)(((lq * 4 + (l15 >> 2)) * 136 + 4 * (l15 & 3)) * 2);
#pragma unroll
                  for (int k2 = 0; k2 < 2; ++k2) {
                    u32x2 f[16];
                    const unsigned vb = va + (unsigned)k2 * 8704u;
                    asm volatile("ds_read_b64_tr_b16 %0, %16\n\tds_read_b64_tr_b16 %1, %16 offset:4352\n\tds_read_b64_tr_b16 %2, %16 offset:32\n\tds_read_b64_tr_b16 %3, %16 offset:4384\n\t"
                                 "ds_read_b64_tr_b16 %4, %16 offset:64\n\tds_read_b64_tr_b16 %5, %16 offset:4416\n\tds_read_b64_tr_b16 %6, %16 offset:96\n\tds_read_b64_tr_b16 %7, %16 offset:4448\n\t"
                                 "ds_read_b64_tr_b16 %8, %16 offset:128\n\tds_read_b64_tr_b16 %9, %16 offset:4480\n\tds_read_b64_tr_b16 %10, %16 offset:160\n\tds_read_b64_tr_b16 %11, %16 offset:4512\n\t"
                                 "ds_read_b64_tr_b16 %12, %16 offset:192\n\tds_read_b64_tr_b16 %13, %16 offset:4544\n\tds_read_b64_tr_b16 %14, %16 offset:224\n\tds_read_b64_tr_b16 %15, %16 offset:4576\n\ts_waitcnt lgkmcnt(0)"
                                 : "=&v"(f[0]), "=&v"(f[1]), "=&v"(f[2]), "=&v"(f[3]), "=&v"(f[4]), "=&v"(f[5]), "=&v"(f[6]), "=&v"(f[7]),
                                   "=&v"(f[8]), "=&v"(f[9]), "=&v"(f[10]), "=&v"(f[11]), "=&v"(f[12]), "=&v"(f[13]), "=&v"(f[14]), "=&v"(f[15]) : "v"(vb) : "memory");
#pragma unroll
                    for (int db = 0; db < 8; ++db) { u32x4 w; w.x = f[2 * db].x; w.y = f[2 * db].y; w.z = f[2 * db + 1].x; w.w = f[2 * db + 1].y;
                        o[db] = mfma16(__builtin_bit_cast(bf16x8, w), Bp[k2], o[db]); }
                  } }
            }
        }
#undef ATT_LOAD
        const float inv = 1.0f / lrun;
        bf16_t* op = ATT + (size_t)(qrow0 + wq * 16 + l15) * DM + head * 128 + lq * 4;
#pragma unroll
        for (int db = 0; db < 8; ++db) { u32x2 w; w.x = pk2(o[db][0] * inv, o[db][1] * inv); w.y = pk2(o[db][2] * inv, o[db][3] * inv); *(u32x2*)(op + db * 16) = w; }
    }
}

__device__ __forceinline__ void norm_phase(const Params& p) {
    const int lane = threadIdx.x & 63, gw = blockIdx.x * 8 + (threadIdx.x >> 6), nw = gridDim.x * 8;
    bf16_t* Y = (bf16_t*)(p.ws + OFF_Y); const bf16_t* Z = (const bf16_t*)(p.ws + OFF_Z); const float* nwt = p.in[12];
    for (int item0 = gw; item0 < MT * 8; item0 += 4 * nw) {
        u32x4 yv[4], zv[4]; float wv[4][8];
#pragma unroll
        for (int k = 0; k < 4; ++k) { const int item = item0 + k * nw; if (item < MT * 8) { const size_t base = (size_t)(item >> 3) * SI + (item & 7) * 512 + lane * 8;
            yv[k] = *(const u32x4*)(Y + base); zv[k] = __builtin_nontemporal_load((const u32x4*)(Z + base)); load8f(nwt + (item & 7) * 512 + lane * 8, wv[k]); } }
#pragma unroll
        for (int k = 0; k < 4; ++k) { const int item = item0 + k * nw; if (item < MT * 8) { const size_t base = (size_t)(item >> 3) * SI + (item & 7) * 512 + lane * 8;
            float y[8], z[8]; unpack8(yv[k], y); unpack8(zv[k], z);
            float ss = 0.f;
#pragma unroll
            for (int q = 0; q < 8; ++q) { y[q] = y[q] * fsilu(z[q]); ss += y[q] * y[q]; }
#pragma unroll
            for (int off = 1; off < 64; off <<= 1) ss += __shfl_xor(ss, off, 64);
            const float rs = rsqrtf(ss * (1.0f / 512.0f) + 1e-5f);
            u32x4 w; w.x = pk2(y[0] * rs * wv[k][0], y[1] * rs * wv[k][1]); w.y = pk2(y[2] * rs * wv[k][2], y[3] * rs * wv[k][3]); w.z = pk2(y[4] * rs * wv[k][4], y[5] * rs * wv[k][5]); w.w = pk2(y[6] * rs * wv[k][6], y[7] * rs * wv[k][7]);
            *(u32x4*)(Y + base) = w; } }
    }
}

__device__ __forceinline__ void ln_phase(const float* src, const float* gam, const float* bet, float* dstf, bf16_t* dstb) {
    const int lane = threadIdx.x & 63, gw = blockIdx.x * 8 + (threadIdx.x >> 6), nw = gridDim.x * 8;
    for (int row0 = gw; row0 < MT; row0 += 2 * nw) {
        f32x4 v[2][8];
#pragma unroll
        for (int h = 0; h < 2; ++h) { const int row = row0 + h * nw; if (row < MT) { const float* s = src + (size_t)row * DM;
#pragma unroll
            for (int k = 0; k < 8; ++k) v[h][k] = __builtin_nontemporal_load((const f32x4*)(s + (k * 64 + lane) * 4)); } }
#pragma unroll
        for (int h = 0; h < 2; ++h) { const int row = row0 + h * nw; if (row < MT) {
            float sum = 0.f;
#pragma unroll
            for (int k = 0; k < 8; ++k) sum += (v[h][k][0] + v[h][k][1]) + (v[h][k][2] + v[h][k][3]);
#pragma unroll
            for (int off = 1; off < 64; off <<= 1) sum += __shfl_xor(sum, off, 64);
            const float mean = sum * (1.0f / 2048.0f);
            float q = 0.f;
#pragma unroll
            for (int k = 0; k < 8; ++k) { v[h][k] -= mean; q += (v[h][k][0] * v[h][k][0] + v[h][k][1] * v[h][k][1]) + (v[h][k][2] * v[h][k][2] + v[h][k][3] * v[h][k][3]); }
#pragma unroll
            for (int off = 1; off < 64; off <<= 1) q += __shfl_xor(q, off, 64);
            const float rs = rsqrtf(q * (1.0f / 2048.0f) + 1e-5f);
#pragma unroll
            for (int k = 0; k < 8; ++k) { const int c = (k * 64 + lane) * 4;
                const f32x4 o = v[h][k] * rs * *(const f32x4*)(gam + c) + *(const f32x4*)(bet + c);
                if (dstb) *(f32x4*)(dstf + (size_t)row * DM + c) = o; else __builtin_nontemporal_store(o, (f32x4*)(dstf + (size_t)row * DM + c));
                if (dstb) { u32x2 w; w.x = pk2(o[0], o[1]); w.y = pk2(o[2], o[3]); *(u32x2*)(dstb + (size_t)row * DM + c) = w; } } } }
    }
}

#define XB_TMO      128
#define XB_XCNT(j)  (256  + 64 * (j))
#define XB_XSUB(j)  (1280 + 64 * (j))
#define XB_XGEN(j)  (2304 + 64 * (j))
#define XB_TOP      3328
#define XB_TOPGEN   3392
#define XCD_BAR_WORDS 3456
#define XB_SPIN_CAP (1u << 18)
#define XB_LAS __attribute__((address_space(3)))
__device__ __forceinline__ unsigned xb_ld(unsigned* p)              { return __hip_atomic_load(p, __ATOMIC_RELAXED, __HIP_MEMORY_SCOPE_AGENT); }
__device__ __forceinline__ unsigned xb_add(unsigned* p, unsigned v) { return __hip_atomic_fetch_add(p, v, __ATOMIC_RELAXED, __HIP_MEMORY_SCOPE_AGENT); }
__device__ __forceinline__ unsigned xb_xcc_id() { return (unsigned)__builtin_amdgcn_s_getreg((3 << 11) | 20) & 0xFu; }
#define XB_SPIN(cond, bar) do { unsigned _sp = 0; while (cond) { __builtin_amdgcn_s_sleep(1); \
    if ((++_sp & 255u) == 0u) { if (xb_ld(&(bar)[XB_TMO])) break; if (_sp > XB_SPIN_CAP) { atomicAdd(&(bar)[XB_TMO], 1u); break; } } } } while (0)
struct XcdBarrier { unsigned* bar; unsigned x; volatile XB_LAS unsigned* st; };
__device__ __forceinline__ XcdBarrier xcd_barrier_post(unsigned* bar, volatile XB_LAS unsigned* st) {
    XcdBarrier b; b.bar = bar; b.x = xb_xcc_id(); b.st = st;
    if (threadIdx.x == 0) (void)xb_add(&bar[XB_XCNT(b.x)], 1u);
    return b;
}
__device__ __forceinline__ void xcd_barrier_complete(unsigned* bar, unsigned x, unsigned& nloc, unsigned& nx) {
    const unsigned G = gridDim.x * gridDim.y * gridDim.z;
    unsigned sum, cnt, mine, sp = 0u;
    for (;;) {
        sum = 0u; cnt = 0u; mine = 0u;
#pragma unroll
        for (unsigned j = 0; j < 16; ++j) { const unsigned c = xb_ld(&bar[XB_XCNT(j)]); sum += c; cnt += (c > 0u) ? 1u : 0u; mine = (j == x) ? c : mine; }
        if (sum == G) break;
        __builtin_amdgcn_s_sleep(1);
        if ((++sp & 255u) == 0u) { if (xb_ld(&bar[XB_TMO])) break; if (sp > XB_SPIN_CAP) { atomicAdd(&bar[XB_TMO], 1u); break; } }
    }
    nloc = mine > 0u ? mine : 1u; nx = cnt > 0u ? cnt : 1u;
}
__device__ __forceinline__ void xcd_barrier(const XcdBarrier& b) {
    asm volatile("s_waitcnt vmcnt(0)" ::: "memory");
    __syncthreads();
    if (threadIdx.x == 0) {
        unsigned* bar = b.bar;
        __builtin_amdgcn_s_waitcnt(0);
        unsigned nloc = b.st[0], nx = b.st[1];
        if (nloc == 0u) { xcd_barrier_complete(bar, b.x, nloc, nx); b.st[0] = nloc; b.st[1] = nx; }
        const unsigned old = xb_add(&bar[XB_XSUB(b.x)], 1u);
        const unsigned gen = old / nloc;
        if (old + 1u == (gen + 1u) * nloc) {
            __builtin_amdgcn_fence(__ATOMIC_RELEASE, "agent");
            asm volatile("s_waitcnt vmcnt(0)" ::: "memory");
            const unsigned og = xb_add(&bar[XB_TOP], 1u);
            const unsigned tg = og / nx;
            if (og + 1u == (tg + 1u) * nx) xb_add(&bar[XB_TOPGEN], 1u);
            else XB_SPIN(xb_ld(&bar[XB_TOPGEN]) == tg, bar);
            __builtin_amdgcn_fence(__ATOMIC_ACQUIRE, "agent");
            xb_add(&bar[XB_XGEN(b.x)], 1u);
            asm volatile("s_waitcnt vmcnt(0)" ::: "memory");
        } else {
            XB_SPIN(xb_ld(&bar[XB_XGEN(b.x)]) == gen, bar);
            __builtin_amdgcn_fence(__ATOMIC_ACQUIRE, "agent");
            asm volatile("s_waitcnt vmcnt(0)" ::: "memory");
        }
    }
    __syncthreads();
}

__global__ void __launch_bounds__(512, 2) mega(Params p) {
    const int lo = p.ph_lo, hi = p.ph_hi;
    PG8_LAS unsigned char* lds = (PG8_LAS unsigned char*)g_lds;
    const int G = gridDim.x, c = blockIdx.x;
    unsigned char* ws = p.ws;
#ifndef PHMASK
#define PHMASK 0x7ff
#endif
#define IN(k) (((PHMASK >> (k)) & 1) && lo <= (k) && (k) < hi)
    volatile XB_LAS unsigned* xst = (volatile XB_LAS unsigned*)(lds + 131072 + 512);
    if (threadIdx.x < 4) xst[threadIdx.x] = 0u;
    __syncthreads();
    const XcdBarrier xbar = xcd_barrier_post((unsigned*)(ws + OFF_BAR), xst);
#define SEAM(k) do { if (IN((k) + 1)) { if ((k) == 0) cg::this_grid().sync(); else xcd_barrier(xbar); } } while (0)
    if (IN(0)) { REPS(0) phase0(p); SEAM(0); }
    unsigned* ctl = (unsigned*)(ws + OFF_CTL);
    if (IN(1)) {
        pg8::Gemm g{(const bf16_t*)(ws + OFF_XB), (const bf16_t*)(ws + OFF_WIN), MT, NIN, DM}; pg8::TailOrder S; S.init(MT, NIN, DM, G, c, 0);
        EpiIn E{ws, p.out, p.in[9]};
        REPS(1) pg8::gemm_phase<EpiIn, pg8::TailOrder>(lds, g, S, E, p.out + O_YP, ctl + 0);
        SEAM(1);
    }
    if (IN(2)) { REPS(2) conv_phase(p); SEAM(2); }
#ifdef SSD_PROBE
    if (IN(3)) { for (int rep = 0; rep < 2; ++rep) ssd_phase(p, rep == 0 ? SSD_PROBE : 0); REPS(13) attn_phase(p); SEAM(3); }
#else
    if (IN(3)) { ssd_phase(p, 0); REPS(13) attn_phase(p); SEAM(3); }
#endif
    if (IN(4)) {
        norm_phase(p);
        __syncthreads();
        tr_cvt<2>(p.in[19], 2 * DFF, DM, (bf16_t*)(ws + OFF_WGU), 2 * DFF);
        tr_cvt<0>(p.in[20], DM, DFF, (bf16_t*)(ws + OFF_WDN), DM);
        SEAM(4);
    }
    if (IN(5)) {
        { pg8::Gemm g{(const bf16_t*)(ws + OFF_Y), (const bf16_t*)(ws + OFF_WSSD), MT, DM, SI}; pg8::TailOrder S; S.init(MT, DM, SI, G, c, 0);
#ifdef P5_OLD
          EpiSsdOut E{p.out + O_YP, (const bf16_t*)(ws + OFF_GT)};
#else
          EpiSsdOut E{(float*)(ws + OFF_XC), (const bf16_t*)(ws + OFF_GT)};
#endif
          pg8::gemm_phase<EpiSsdOut, pg8::TailOrder>(lds, g, S, E, p.out + O_YP, ctl + 128); }
        xcd_barrier(xbar);
        { pg8::Gemm g{(const bf16_t*)(ws + OFF_ATT), (const bf16_t*)(ws + OFF_WATT), MT, DM, DM}; pg8::TailOrder S; S.init(MT, DM, DM, G, c, 0);
#ifdef P5_OLD
          EpiAttOut E{p.out + O_YP, (const bf16_t*)(ws + OFF_GT), (bf16_t*)(ws + OFF_MIXED)};
#else
          EpiAttOut E{(const float*)(ws + OFF_XC), (const bf16_t*)(ws + OFF_GT), (bf16_t*)(ws + OFF_MIXED)};
#endif
          pg8::gemm_phase<EpiAttOut, pg8::TailOrder>(lds, g, S, E, p.out + O_YP, ctl + 640); }
        SEAM(5);
    }
    if (IN(6)) {
        pg8::Gemm g{(const bf16_t*)(ws + OFF_MIXED), (const bf16_t*)(ws + OFF_WO), MT, DM, DM}; pg8::TailOrder S; S.init(MT, DM, DM, G, c, 0);
        EpiResid E{p.in[0], p.in[1], p.out + O_YP};
        pg8::gemm_phase<EpiResid, pg8::TailOrder>(lds, g, S, E, (float*)(ws + OFF_GT), ctl + 256);
        SEAM(6);
    }
    if (IN(7)) { ln_phase(p.out + O_YP, p.in[17], p.in[18], (float*)(ws + OFF_H), (bf16_t*)(ws + OFF_HB)); SEAM(7); }
    if (IN(8)) {
        pg8::Gemm g{(const bf16_t*)(ws + OFF_HB), (const bf16_t*)(ws + OFF_WGU), MT, 2 * DFF, DM}; pg8::TailOrder S; S.init(MT, 2 * DFF, DM, G, c, 0);
        EpiGateUp E{(bf16_t*)(ws + OFF_ACT)};
        REPS(8) pg8::gemm_phase<EpiGateUp, pg8::TailOrder>(lds, g, S, E, p.out + O_YP, ctl + 384);
        SEAM(8);
    }
    if (IN(9)) {
        pg8::Gemm g{(const bf16_t*)(ws + OFF_ACT), (const bf16_t*)(ws + OFF_WDN), MT, DM, DFF}; pg8::TailOrder S; S.init(MT, DM, DFF, G, c, 0);
        EpiResid E{(const float*)(ws + OFF_H), (const float*)(ws + OFF_H) + (size_t)MP * DM, p.out + O_YP};
        pg8::gemm_phase<EpiResid, pg8::TailOrder>(lds, g, S, E, (float*)(ws + OFF_GT), ctl + 512);
        SEAM(9);
    }
    if (IN(10)) { ln_phase(p.out + O_YP, p.in[21], p.in[22], p.out + O_YP, nullptr); }
#undef IN
#undef SEAM
}

extern "C" void kernel_launch(void* const* d_in, const int* in_sizes, int n_in, void* d_out, int out_size, void* d_ws, size_t ws_size, hipStream_t stream) {
    static int grid = 0;
    if (grid == 0) {
        if (n_in != 23 || ws_size < WS_END) { fprintf(stderr, "kernel_launch: unexpected n_in %d or ws_size %zu (< %zu)\n", n_in, ws_size, (size_t)WS_END); grid = -1; return; }
        int dev = 0, cus = 0, per_cu = 0;
        hipGetDevice(&dev); hipDeviceGetAttribute(&cus, hipDeviceAttributeMultiprocessorCount, dev);
        if (hipFuncSetAttribute((const void*)mega, hipFuncAttributeMaxDynamicSharedMemorySize, LDS_BYTES) != hipSuccess) { fprintf(stderr, "kernel_launch: hipFuncSetAttribute failed\n"); grid = -1; return; }
        if (hipOccupancyMaxActiveBlocksPerMultiprocessor(&per_cu, (const void*)mega, 512, LDS_BYTES) != hipSuccess || per_cu < 1) { fprintf(stderr, "kernel_launch: occupancy query gave %d\n", per_cu); (void)hipGetLastError(); grid = -1; return; }
        grid = cus;
    }
    if (grid < 0) return;
    if (hipMemsetAsync((char*)d_ws + OFF_BAR, 0, XCD_BAR_WORDS * 4, stream) != hipSuccess) { fprintf(stderr, "kernel_launch: memset of the barrier words failed\n"); return; }
    Params p{};
    for (int i = 0; i < 23; ++i) p.in[i] = (const float*)d_in[i];
    p.out = (float*)d_out; p.ws = (unsigned char*)d_ws;
#if ONE_LAUNCH
    p.ph_lo = 0; p.ph_hi = NPH;
    void* args[] = {&p};
    hipError_t e = hipLaunchCooperativeKernel((const void*)mega, dim3(grid), dim3(512), args, LDS_BYTES, stream);
    if (e != hipSuccess) fprintf(stderr, "cooperative launch failed: %s (grid %d)\n", hipGetErrorString(e), grid);
#else
    for (int ph = 0; ph < NPH; ++ph) { p.ph_lo = ph; p.ph_hi = ph + 1; hipLaunchKernelGGL(mega, dim3(grid), dim3(512), LDS_BYTES, stream, p); }
#endif
}
```

```cpp
#include <hip/hip_runtime.h>
#include <hip/hip_cooperative_groups.h>
#include <cstdio>
namespace cg = cooperative_groups;

#ifndef ONE_LAUNCH
#define ONE_LAUNCH 1
#endif
#ifndef PROBE_REP
#define PROBE_REP -1
#endif
#define REPS(k) for (int rep_ = 0; rep_ < ((PROBE_REP) == (k) ? 2 : 1); ++rep_)

typedef unsigned short bf16_t;
typedef short bf16x8 __attribute__((ext_vector_type(8)));
typedef float f32x4 __attribute__((ext_vector_type(4)));
typedef unsigned u32x4 __attribute__((ext_vector_type(4)));
typedef unsigned u32x2 __attribute__((ext_vector_type(2)));

extern __shared__ __attribute__((aligned(16))) unsigned char g_lds[];

constexpr int MP = 8192, MS = 1024, MT = 9216, DM = 2048, SI = 4096, CD = 6144, DFF = 5632;
constexpr int NIN_SRC = 20544, NIN = 20736;
constexpr float ALPHA = 1.189207115002721f;
constexpr int NPH = 11;
constexpr int LDS_BYTES = 131072 + 512 + 16;
constexpr size_t O_YP = 0, O_CONVP = 18874368, O_SSMP = 18892800, O_KP = 19417088, O_VP = 20465664,
                 O_CONVS = 21514240, O_SSMS = 21809152, O_KS = 30197760, O_VS = 32294912;
constexpr size_t OFF_XB = 0, OFF_WIN = 37748736, OFF_XC = 0, OFF_ACT = 0;
constexpr size_t OFF_XBC = 122683392, OFF_Y = OFF_XBC, OFF_ATT = OFF_XBC + 75497472;
constexpr size_t OFF_Q = 235929600, OFF_KPB = 273678336, OFF_VPB = 307232768, OFF_KSB = 340787200, OFF_VSB = 378535936;
constexpr size_t OFF_WGU = OFF_Q, OFF_WDN = 282066944, OFF_MIXED = 305135616, OFF_HB = 342884352;
constexpr size_t OFF_Z = 416284672, OFF_H = OFF_Z, OFF_GT = 491782144, OFF_DT = 567279616;
constexpr size_t OFF_WSSD = 569638912, OFF_WATT = 586416128, OFF_WO = 594804736, OFF_CTL = 603193344, OFF_BAR = 603197440, WS_END = 603197440 + 16384;

struct Params { const float* in[23]; float* out; unsigned char* ws; int ph_lo, ph_hi; };

typedef __bf16 bf16x2_t __attribute__((ext_vector_type(2)));
typedef float f32x2_t __attribute__((ext_vector_type(2)));
__device__ __forceinline__ unsigned pk2(float lo, float hi) { const f32x2_t v = {lo, hi}; const bf16x2_t r = __builtin_convertvector(v, bf16x2_t); return __builtin_bit_cast(unsigned, r); }
__device__ __forceinline__ bf16_t f2bf(float f) { unsigned u = __float_as_uint(f); u += 0x7FFFu + ((u >> 16) & 1u); return (bf16_t)(u >> 16); }
__device__ __forceinline__ float bf2f(bf16_t b) { return __uint_as_float(((unsigned)b) << 16); }
__device__ __forceinline__ float lo2f(unsigned w) { return __uint_as_float(w << 16); }
__device__ __forceinline__ float hi2f(unsigned w) { return __uint_as_float(w & 0xffff0000u); }
__device__ __forceinline__ float fsig(float x) { return __builtin_amdgcn_rcpf(1.0f + __expf(-x)); }
__device__ __forceinline__ float fsilu(float x) { return x * fsig(x); }
__device__ __forceinline__ u32x4 cvt8(const float* s) {
    const f32x4 a = __builtin_nontemporal_load((const f32x4*)s), b = __builtin_nontemporal_load((const f32x4*)(s + 4));
    u32x4 r; r.x = pk2(a[0], a[1]); r.y = pk2(a[2], a[3]); r.z = pk2(b[0], b[1]); r.w = pk2(b[2], b[3]); return r;
}
__device__ __forceinline__ f32x4 mfma16(bf16x8 a, bf16x8 b, f32x4 c) { return __builtin_amdgcn_mfma_f32_16x16x32_bf16(a, b, c, 0, 0, 0); }

namespace pg8 {
#define PG8_LAS __attribute__((address_space(3)))
constexpr int BM = 256, BK = 64, HALF = 128, HTB = HALF * BK * 2, STAGE_BYTES = 8 * HTB, NXCD = 8, WGM = 8;
__host__ __device__ __forceinline__ int lds_byte(int r, int c) { const int st = (r >> 4) * 2 + (c >> 5), rr = r & 15, cc = c & 31, ob = rr * 64 + cc * 2; return st * 1024 + (ob ^ (((ob >> 9) & 1) << 5)); }
__host__ __device__ __forceinline__ void stage_rc(int b, int& R, int& C) { const int st = b / 1024, sb = b % 1024, swz = sb ^ (((sb >> 9) & 1) << 5); R = (st >> 1) * 16 + swz / 64; C = (st & 1) * 32 + (swz % 64) / 2; }
__host__ __device__ __forceinline__ int perm32(int rho) { const int n = rho >> 4, i = rho & 15; return 8 * (i >> 2) + 4 * n + (i & 3); }
struct Unit { int pm, pn, k0t, nkt, tau, sidx, nsp; };
struct Gemm { const bf16_t* A; const bf16_t* Bt; int M, N, K; };
struct TailOrder {
    int nM, nN, U, G, c, ntK, full, T, s, p5;
    __device__ __forceinline__ void init(int M, int N, int K, int G_, int c_, int p5_) {
        nM = M / BM; nN = N / BM; U = nM * nN; G = G_; c = c_; ntK = K / BK; full = U / G; T = U - full * G; p5 = p5_;
        const int smax = ntK / 4;
        { const int lim = T ? G / T : 1; s = 1; while (s * 2 <= lim && s * 2 <= smax && s * 2 <= 8) s *= 2; }
#ifdef NOSPLIT
        s = 1;
#endif
    }
    __device__ __forceinline__ void tile(int L, Unit& u) const {
        int wgid = L; { const int q = U / NXCD, r = U % NXCD, xcd = wgid % NXCD, off = wgid / NXCD; wgid = (xcd < r ? xcd * (q + 1) : r * (q + 1) + (xcd - r) * q) + off; }
        const int nig = WGM * nN, gid = wgid / nig, fm = gid * WGM, gsz = (nM - fm) < WGM ? (nM - fm) : WGM;
        u.pm = fm + ((wgid % nig) % gsz); u.pn = (wgid % nig) / gsz;
    }
    __device__ __forceinline__ void fill(PG8_LAS unsigned char* lds, int tid) const {
        PG8_LAS int* tab = (PG8_LAS int*)(lds + STAGE_BYTES);
        if (tid < 16) { Unit t; const bool ok = next_(tid, t); tab[tid * 8 + 0] = ok ? t.pm : -1; tab[tid * 8 + 1] = t.pn; tab[tid * 8 + 2] = t.k0t; tab[tid * 8 + 3] = t.nkt; tab[tid * 8 + 4] = t.tau; tab[tid * 8 + 5] = t.sidx; tab[tid * 8 + 6] = t.nsp; }
        __syncthreads();
    }
    __device__ __forceinline__ bool get(PG8_LAS unsigned char* lds, int i, Unit& u) const {
        const PG8_LAS int* tab = (const PG8_LAS int*)(lds + STAGE_BYTES) + i * 8;
        const int pm = __builtin_amdgcn_readfirstlane(tab[0]);
        u.pm = pm; u.pn = __builtin_amdgcn_readfirstlane(tab[1]); u.k0t = __builtin_amdgcn_readfirstlane(tab[2]); u.nkt = __builtin_amdgcn_readfirstlane(tab[3]);
        u.tau = __builtin_amdgcn_readfirstlane(tab[4]); u.sidx = __builtin_amdgcn_readfirstlane(tab[5]); u.nsp = __builtin_amdgcn_readfirstlane(tab[6]);
        return pm >= 0;
    }
    __device__ __forceinline__ bool next_(int i, Unit& u) const {
        u.pm = 0; u.pn = 0; u.k0t = 0; u.nkt = ntK; u.tau = 0; u.sidx = 0; u.nsp = 1;
        if (i < full) { tile(i * G + c, u); return true; }
        if (i == full && T > 0) {
            if (s == 1) { if (c >= T) return false; tile(full * G + c, u); return true; }
            if (c >= T * s) return false;
            const int tau = c % T, j = c / T; tile(full * G + tau, u); u.tau = tau; u.sidx = j; u.nsp = s;
            int k0p, np;
            { const int pairs = ntK / 2, base = pairs / s, rem = pairs % s; k0p = j * base + (j < rem ? j : rem); np = base + (j < rem ? 1 : 0); }
            u.k0t = 2 * k0p; u.nkt = 2 * np; return true;
        }
        return false;
    }
};

template <class Epi, class Sched>
__device__ __forceinline__ void gemm_phase(PG8_LAS unsigned char* lds, const Gemm g, const Sched& S, const Epi& E, float* part, unsigned* cnt) {
    int tid_ = threadIdx.x;
    const int tid = tid_, wid = __builtin_amdgcn_readfirstlane(tid >> 6), lane = tid & 63, wr = wid >> 2, wc = wid & 3, fr = lane & 15, fq = lane >> 4;
    S.fill(lds, tid);
    __builtin_amdgcn_sched_barrier(0);
    const int K = g.K;
    unsigned voffA[2], voffB[2];
#pragma unroll
    for (int i = 0; i < 2; ++i) { int R, C; stage_rc(tid * 16 + i * 8192, R, C); const int Rb = Epi::PERM ? ((R & ~31) + perm32(R & 31)) : R;
        voffA[i] = (unsigned)(R * K + C) * 2u; voffB[i] = (unsigned)(Rb * K + C) * 2u; }
    const size_t kstep = (size_t)(BK * 2);
    const size_t hstep = (size_t)HALF * K * 2;
    const size_t tstep = 2 * hstep;
    const unsigned ldsw = (unsigned)wid * 1024u;
    const int aoff = lds_byte(wr * 64 + fr, fq * 8), boff = lds_byte(wc * 32 + fr, fq * 8);
#define PG8_SA(b, h) (((b) * 2 + (h)) * HTB)
#define PG8_SB(b, h) ((4 + (b) * 2 + (h)) * HTB)
#define PG8_STAGE(bufoff, gbase, voff) do { _Pragma("unroll") for (int _i = 0; _i < 2; ++_i) \
        __builtin_amdgcn_global_load_lds((const unsigned*)((const char*)(gbase) + (voff)[_i]), (PG8_LAS unsigned*)(lds + (bufoff) + ldsw + _i * 8192), 16, 0, 0); } while (0)
#define PG8_LDA(dst, b, h) do { _Pragma("unroll") for (int m = 0; m < 4; ++m) _Pragma("unroll") for (int k = 0; k < 2; ++k) dst[m][k] = *(const PG8_LAS bf16x8*)(lds + PG8_SA(b, h) + aoff + m * 2048 + k * 1024); } while (0)
#define PG8_LDB(dst, b, h) do { _Pragma("unroll") for (int n = 0; n < 2; ++n) _Pragma("unroll") for (int k = 0; k < 2; ++k) dst[n][k] = *(const PG8_LAS bf16x8*)(lds + PG8_SB(b, h) + boff + n * 2048 + k * 1024); } while (0)
#define PG8_MMA(ai, bj, At, Bt) do { __builtin_amdgcn_s_setprio(1); _Pragma("unroll") for (int m = 0; m < 4; ++m) _Pragma("unroll") for (int n = 0; n < 2; ++n) _Pragma("unroll") for (int k = 0; k < 2; ++k) \
        acc[ai][bj][m][n] = __builtin_amdgcn_mfma_f32_16x16x32_bf16(Bt[n][k], At[m][k], acc[ai][bj][m][n], 0, 0, 0); __builtin_amdgcn_s_setprio(0); } while (0)
#define PG8_WAIT_V(n) asm volatile("s_waitcnt vmcnt(" #n ")" ::: "memory")
#define PG8_WAIT_L(n) asm volatile("s_waitcnt lgkmcnt(" #n ")" ::: "memory")
#define PG8_BAR __builtin_amdgcn_s_barrier()
#define PG8_SCHED __builtin_amdgcn_sched_barrier(0)
    Unit cur, nxt; int ui = 0;
    if (!S.get(lds, 0, cur)) return;
    f32x4 acc[2][2][4][2];
#pragma unroll
    for (int a = 0; a < 2; ++a)
#pragma unroll
        for (int b = 0; b < 2; ++b)
#pragma unroll
            for (int m = 0; m < 4; ++m)
#pragma unroll
                for (int n = 0; n < 2; ++n) acc[a][b][m][n] = (f32x4){0.f, 0.f, 0.f, 0.f};
    bf16x8 At[4][2], B0[2][2], B1[2][2];
    const char* cA = (const char*)g.A + (size_t)cur.pm * tstep + (size_t)cur.k0t * kstep; const char* cB = (const char*)g.Bt + (size_t)cur.pn * tstep + (size_t)cur.k0t * kstep;
    PG8_STAGE(PG8_SB(0, 0), cB, voffB); PG8_STAGE(PG8_SB(0, 1), cB + hstep, voffB); PG8_STAGE(PG8_SA(0, 0), cA, voffA); PG8_STAGE(PG8_SA(0, 1), cA + hstep, voffA);
    if (wr == 1) PG8_BAR;
    PG8_WAIT_V(2); PG8_BAR;
    PG8_STAGE(PG8_SB(1, 0), cB + kstep, voffB); PG8_STAGE(PG8_SA(1, 0), cA + kstep, voffA); PG8_STAGE(PG8_SB(1, 1), cB + hstep + kstep, voffB);
    PG8_WAIT_V(6); PG8_BAR;
    for (;;) {
        const bool has_next = S.get(lds, ui + 1, nxt);
        const char* nA = has_next ? (const char*)g.A + (size_t)nxt.pm * tstep + (size_t)nxt.k0t * kstep : cA; const char* nB = has_next ? (const char*)g.Bt + (size_t)nxt.pn * tstep + (size_t)nxt.k0t * kstep : cB;
        const int nt = cur.nkt;
        for (int t = 0; t < nt; t += 2) {
            const bool last = (t == nt - 2);
            const char* a1 = cA + (size_t)(t + 1) * kstep;
            const char* a2 = last ? nA : cA + (size_t)(t + 2) * kstep; const char* b2 = last ? nB : cB + (size_t)(t + 2) * kstep;
            const char* a3 = a2 + kstep; const char* b3 = b2 + kstep;
            PG8_LDB(B0, 0, 0); PG8_LDB(B1, 0, 1); PG8_SCHED; PG8_LDA(At, 0, 0); PG8_STAGE(PG8_SA(1, 1), a1 + hstep, voffA);
            PG8_WAIT_V(8); PG8_WAIT_L(0); PG8_BAR; PG8_MMA(0, 0, At, B0); PG8_MMA(0, 1, At, B1); PG8_BAR; PG8_SCHED;
            PG8_LDA(At, 0, 1); PG8_STAGE(PG8_SB(0, 0), b2, voffB); PG8_STAGE(PG8_SB(0, 1), b2 + hstep, voffB); PG8_STAGE(PG8_SA(0, 0), a2, voffA);
            PG8_WAIT_V(8); PG8_WAIT_L(0); PG8_BAR; PG8_MMA(1, 0, At, B0); PG8_MMA(1, 1, At, B1); PG8_BAR; PG8_SCHED;
            PG8_LDB(B0, 1, 0); PG8_LDB(B1, 1, 1); PG8_SCHED; PG8_LDA(At, 1, 0); PG8_STAGE(PG8_SA(0, 1), a2 + hstep, voffA);
            PG8_WAIT_V(8); PG8_WAIT_L(0); PG8_BAR; PG8_MMA(0, 0, At, B0); PG8_MMA(0, 1, At, B1); PG8_BAR; PG8_SCHED;
            PG8_LDA(At, 1, 1); PG8_STAGE(PG8_SB(1, 0), b3, voffB); PG8_STAGE(PG8_SB(1, 1), b3 + hstep, voffB); PG8_STAGE(PG8_SA(1, 0), a3, voffA);
            PG8_WAIT_V(8); PG8_WAIT_L(0); PG8_BAR; PG8_MMA(1, 0, At, B0); PG8_MMA(1, 1, At, B1); PG8_BAR; PG8_SCHED;
        }
        if (wr == 0) PG8_BAR;
        bool doit = true, reduced = false;
        if (!has_next) {
            PG8_WAIT_V(0);
            PG8_BAR;
            if (cur.nsp > 1) {
                {
                    float* q = part + (size_t)(cur.tau * cur.nsp + cur.sidx) * 65536 + tid * 4;
#pragma unroll
                    for (int a = 0; a < 2; ++a)
#pragma unroll
                        for (int b = 0; b < 2; ++b)
#pragma unroll
                            for (int m = 0; m < 4; ++m)
#pragma unroll
                                for (int n = 0; n < 2; ++n) { asm volatile("global_store_dwordx4 %0, %1, off sc1" :: "v"(q), "v"(acc[a][b][m][n]) : "memory"); q += 2048; asm volatile("" : "+v"(q)); }
                }
                asm volatile("s_waitcnt vmcnt(0)" ::: "memory");
                __syncthreads();
                if (tid == 0) {
                    __hip_atomic_fetch_add(cnt + cur.tau, 1u, __ATOMIC_RELAXED, __HIP_MEMORY_SCOPE_AGENT);
                    while (__hip_atomic_load(cnt + cur.tau, __ATOMIC_RELAXED, __HIP_MEMORY_SCOPE_AGENT) < (unsigned)cur.nsp) __builtin_amdgcn_s_sleep(4);
                }
                __syncthreads();
                const int np = 16 / cur.nsp;
                const float* qt = part + (size_t)(cur.tau * cur.nsp) * 65536 + tid * 4;
                for (int pi = 0; pi < np; ++pi) {
                    const int vp = cur.sidx * np + pi, a = vp >> 3, b = (vp >> 2) & 1, m = vp & 3;
                    f32x4 s0 = (f32x4){0.f, 0.f, 0.f, 0.f}, s1 = s0;
                    for (int j = 0; j < cur.nsp; ++j) {
                        const unsigned long long* q8 = (const unsigned long long*)(qt + (size_t)j * 65536 + (size_t)vp * 4096);
                        const unsigned long long w0 = __hip_atomic_load(q8, __ATOMIC_RELAXED, __HIP_MEMORY_SCOPE_AGENT), w1 = __hip_atomic_load(q8 + 1, __ATOMIC_RELAXED, __HIP_MEMORY_SCOPE_AGENT);
                        const unsigned long long w2 = __hip_atomic_load(q8 + 1024, __ATOMIC_RELAXED, __HIP_MEMORY_SCOPE_AGENT), w3 = __hip_atomic_load(q8 + 1025, __ATOMIC_RELAXED, __HIP_MEMORY_SCOPE_AGENT);
                        s0 += (f32x4){__uint_as_float((unsigned)w0), __uint_as_float((unsigned)(w0 >> 32)), __uint_as_float((unsigned)w1), __uint_as_float((unsigned)(w1 >> 32))};
                        s1 += (f32x4){__uint_as_float((unsigned)w2), __uint_as_float((unsigned)(w2 >> 32)), __uint_as_float((unsigned)w3), __uint_as_float((unsigned)(w3 >> 32))};
                    }
                    E.pair(cur, a, b, m, wr, wc, fr, fq, s0, s1);
                }
                doit = false;
            }
        }
        if (doit) E(acc, cur, wr, wc, fr, fq, reduced);
        if (!has_next) break;
#pragma unroll
        for (int a = 0; a < 2; ++a)
#pragma unroll
            for (int b = 0; b < 2; ++b)
#pragma unroll
                for (int m = 0; m < 4; ++m)
#pragma unroll
                    for (int n = 0; n < 2; ++n) acc[a][b][m][n] = (f32x4){0.f, 0.f, 0.f, 0.f};
        cur = nxt; cA = nA; cB = nB; ++ui;
        if (wr == 1) PG8_BAR;
    }
    __syncthreads();
#undef PG8_SA
#undef PG8_SB
#undef PG8_STAGE
#undef PG8_LDA
#undef PG8_LDB
#undef PG8_MMA
#undef PG8_WAIT_V
#undef PG8_WAIT_L
#undef PG8_BAR
#undef PG8_SCHED
}
}
using pg8::Unit;

__device__ __forceinline__ u32x4 pack8(const f32x4 a, const f32x4 b) { u32x4 w; w.x = pk2(a[0], a[1]); w.y = pk2(a[2], a[3]); w.z = pk2(b[0], b[1]); w.w = pk2(b[2], b[3]); return w; }

#define EPI_FULL_TILE() \
    __device__ __forceinline__ void operator()(const f32x4 (&acc)[2][2][4][2], const Unit& u, int wr, int wc, int fr, int fq, bool) const { \
        _Pragma("unroll") for (int ai = 0; ai < 2; ++ai) _Pragma("unroll") for (int m = 0; m < 4; ++m) _Pragma("unroll") for (int bj = 0; bj < 2; ++bj) \
            pair(u, ai, bj, m, wr, wc, fr, fq, acc[ai][bj][m][0], acc[ai][bj][m][1]); }

struct EpiIn {
    static constexpr bool PERM = true;
    unsigned char* ws; float* out; const float* dt_bias;
    __device__ __forceinline__ void pair(const Unit& u, int ai, int bj, int m, int wr, int wc, int fr, int fq, f32x4 v0, f32x4 v1) const {
        const int pn = u.pn;
        bf16_t* const Z = (bf16_t*)(ws + OFF_Z); bf16_t* const XBC = (bf16_t*)(ws + OFF_XBC); bf16_t* const Q = (bf16_t*)(ws + OFF_Q); bf16_t* const KP = (bf16_t*)(ws + OFF_KPB); bf16_t* const VP = (bf16_t*)(ws + OFF_VPB);
        bf16_t* const KS = (bf16_t*)(ws + OFF_KSB); bf16_t* const VS = (bf16_t*)(ws + OFF_VSB); bf16_t* const GT = (bf16_t*)(ws + OFF_GT); float* const DT = (float*)(ws + OFF_DT);
        const int row = u.pm * 256 + wr * 64 + fr + ai * 128 + m * 16, cloc = wc * 32 + 8 * fq + bj * 128;
        if (pn < 16) {
            *(u32x4*)(Z + (size_t)row * SI + pn * 256 + cloc) = pack8(v0, v1);
        } else if (pn < 40) {
            const int c = (pn - 16) * 256 + cloc;
            *(u32x4*)(XBC + (size_t)row * CD + c) = pack8(v0, v1);
            float* o = nullptr;
            if (row < MP) { if (row >= MP - 3) o = out + O_CONVP + (size_t)(row - (MP - 3)) * CD + c; }
            else { const int t = (row - MP) & 63, b = (row - MP) >> 6; if (t >= 61) o = out + O_CONVS + (size_t)(b * 3 + t - 61) * CD + c; }
            if (o) { __builtin_nontemporal_store(v0, (f32x4*)o); __builtin_nontemporal_store(v1, (f32x4*)(o + 4)); }
        } else if (pn < 48) {
            *(u32x4*)(Q + (size_t)row * DM + (pn - 40) * 256 + cloc) = pack8(v0, v1);
        } else if (pn < 64) {
            const bool isk = pn < 56;
            const int c = (pn - (isk ? 48 : 56)) * 256 + cloc;
            bf16_t* d; float* o = nullptr;
            if (row < MP) { d = (isk ? KP : VP) + (size_t)row * DM + c; if (row >= MP - 512) o = out + (isk ? O_KP : O_VP) + (size_t)(row - (MP - 512)) * DM + c; }
            else { const int t = (row - MP) & 63, b = (row - MP) >> 6; d = (isk ? KS : VS) + ((size_t)b * 576 + 512 + t) * DM + c; o = out + (isk ? O_KS : O_VS) + (size_t)(row - MP) * DM + c; }
            *(u32x4*)d = pack8(v0, v1);
            if (o) { __builtin_nontemporal_store(v0, (f32x4*)o); __builtin_nontemporal_store(v1, (f32x4*)(o + 4)); }
        } else if (pn < 80) {
#pragma unroll
            for (int j = 0; j < 4; ++j) { v0[j] = fsig(v0[j]); v1[j] = fsig(v1[j]); }
            *(u32x4*)(GT + (size_t)row * 4096 + (pn - 64) * 256 + cloc) = pack8(v0, v1);
        } else {
            if (cloc < 64) {
                const f32x4 b0 = *(const f32x4*)(dt_bias + cloc), b1 = *(const f32x4*)(dt_bias + cloc + 4);
#pragma unroll
                for (int j = 0; j < 4; ++j) { float a = v0[j] + b0[j]; v0[j] = a > 20.f ? a : log1pf(__expf(a)); float c2 = v1[j] + b1[j]; v1[j] = c2 > 20.f ? c2 : log1pf(__expf(c2)); }
                *(f32x4*)(DT + (size_t)row * 64 + cloc) = v0; *(f32x4*)(DT + (size_t)row * 64 + cloc + 4) = v1;
            }
        }
    }
    template <int R> __device__ __forceinline__ void body(const f32x4 (&acc)[2][2][4][2], const Unit& u, int wr, int wc, int fr, int fq, bf16_t* dst, unsigned pitch, unsigned cbase, bf16_t* dstS, float* oP, float* oS) const {
        const int rbase = u.pm * 256 + wr * 64 + fr; const unsigned cl = cbase + wc * 32 + 8 * fq;
#pragma unroll
        for (int ai = 0; ai < 2; ++ai)
#pragma unroll
            for (int m = 0; m < 4; ++m) {
                const int row = rbase + ai * 128 + m * 16;
#pragma unroll
                for (int bj = 0; bj < 2; ++bj) {
                    const unsigned c = cl + bj * 128;
                    f32x4 v0 = acc[ai][bj][m][0], v1 = acc[ai][bj][m][1];
                    if (R == 0) { *(u32x4*)(dst + ((unsigned)row * pitch + c)) = pack8(v0, v1); }
                    if (R == 1) {
                        *(u32x4*)(dst + ((unsigned)row * pitch + c)) = pack8(v0, v1);
                        float* o = nullptr;
                        if (row < MP) { if (row >= MP - 3) o = oP + ((unsigned)(row - (MP - 3)) * CD + c); }
                        else { const int t = (row - MP) & 63, b = (row - MP) >> 6; if (t >= 61) o = oS + ((unsigned)(b * 3 + t - 61) * CD + c); }
                        if (o) { __builtin_nontemporal_store(v0, (f32x4*)o); __builtin_nontemporal_store(v1, (f32x4*)(o + 4)); }
                    }
                    if (R == 2) {
                        if (row < MP) { *(u32x4*)(dst + ((unsigned)row * DM + c)) = pack8(v0, v1);
                            if (row >= MP - 512) { float* o = oP + ((unsigned)(row - (MP - 512)) * DM + c); __builtin_nontemporal_store(v0, (f32x4*)o); __builtin_nontemporal_store(v1, (f32x4*)(o + 4)); } }
                        else { const int t = (row - MP) & 63, b = (row - MP) >> 6;
                            *(u32x4*)(dstS + ((unsigned)(b * 576 + 512 + t) * DM + c)) = pack8(v0, v1);
                            float* o = oS + ((unsigned)(row - MP) * DM + c); __builtin_nontemporal_store(v0, (f32x4*)o); __builtin_nontemporal_store(v1, (f32x4*)(o + 4)); }
                    }
                    if (R == 3) {
#pragma unroll
                        for (int j = 0; j < 4; ++j) { v0[j] = fsig(v0[j]); v1[j] = fsig(v1[j]); }
                        *(u32x4*)(dst + ((unsigned)row * pitch + c)) = pack8(v0, v1);
                    }
                    if (R == 4) {
                        if (c < 64) {
                            const f32x4 b0 = *(const f32x4*)(dt_bias + c), b1 = *(const f32x4*)(dt_bias + c + 4);
#pragma unroll
                            for (int j = 0; j < 4; ++j) { float a = v0[j] + b0[j]; v0[j] = a > 20.f ? a : log1pf(__expf(a)); float c2 = v1[j] + b1[j]; v1[j] = c2 > 20.f ? c2 : log1pf(__expf(c2)); }
                            float* o = (float*)dst + ((unsigned)row * 64 + c); __builtin_nontemporal_store(v0, (f32x4*)o); __builtin_nontemporal_store(v1, (f32x4*)(o + 4));
                        }
                    }
                }
            }
    }
    __device__ __forceinline__ void operator()(const f32x4 (&acc)[2][2][4][2], const Unit& u, int wr, int wc, int fr, int fq, bool) const {
        const int pn = u.pn;
        if (pn < 16) body<0>(acc, u, wr, wc, fr, fq, (bf16_t*)(ws + OFF_Z), SI, pn * 256, nullptr, nullptr, nullptr);
        else if (pn < 40) body<1>(acc, u, wr, wc, fr, fq, (bf16_t*)(ws + OFF_XBC), CD, (pn - 16) * 256, nullptr, out + O_CONVP, out + O_CONVS);
        else if (pn < 48) body<0>(acc, u, wr, wc, fr, fq, (bf16_t*)(ws + OFF_Q), DM, (pn - 40) * 256, nullptr, nullptr, nullptr);
        else if (pn < 56) body<2>(acc, u, wr, wc, fr, fq, (bf16_t*)(ws + OFF_KPB), DM, (pn - 48) * 256, (bf16_t*)(ws + OFF_KSB), out + O_KP, out + O_KS);
        else if (pn < 64) body<2>(acc, u, wr, wc, fr, fq, (bf16_t*)(ws + OFF_VPB), DM, (pn - 56) * 256, (bf16_t*)(ws + OFF_VSB), out + O_VP, out + O_VS);
        else if (pn < 80) body<3>(acc, u, wr, wc, fr, fq, (bf16_t*)(ws + OFF_GT), 4096, (pn - 64) * 256, nullptr, nullptr, nullptr);
        else body<4>(acc, u, wr, wc, fr, fq, (bf16_t*)(ws + OFF_DT), 64, 0, nullptr, nullptr, nullptr);
    }
};

__device__ __forceinline__ f32x4 gate4(const bf16_t* g) { const u32x2 w = *(const u32x2*)g; return (f32x4){lo2f(w.x), hi2f(w.x), lo2f(w.y), hi2f(w.y)}; }
struct EpiSsdOut {
    static constexpr bool PERM = false;
    float* mixp; const bf16_t* GT;
    __device__ __forceinline__ void pair(const Unit& u, int ai, int bj, int m, int wr, int wc, int fr, int fq, f32x4 v0, f32x4 v1) const {
        const int row = u.pm * 256 + wr * 64 + fr + ai * 128 + m * 16; const unsigned col = u.pn * 256 + wc * 32 + 4 * fq + bj * 128;
        *(f32x4*)(mixp + ((unsigned)row * DM + col)) = v0 * gate4(GT + ((unsigned)row * 4096 + col));
        *(f32x4*)(mixp + ((unsigned)row * DM + col + 16)) = v1 * gate4(GT + ((unsigned)row * 4096 + col + 16));
    }
    EPI_FULL_TILE()
};
struct EpiAttOut {
    static constexpr bool PERM = false;
    const float* mixp; const bf16_t* GT; bf16_t* MIXED;
    __device__ __forceinline__ void pair(const Unit& u, int ai, int bj, int m, int wr, int wc, int fr, int fq, f32x4 v0, f32x4 v1) const {
        const int row = u.pm * 256 + wr * 64 + fr + ai * 128 + m * 16; const unsigned col = u.pn * 256 + wc * 32 + 4 * fq + bj * 128;
        v0 = *(const f32x4*)(mixp + ((unsigned)row * DM + col)) + v0 * gate4(GT + ((unsigned)row * 4096 + 2048 + col));
        v1 = *(const f32x4*)(mixp + ((unsigned)row * DM + col + 16)) + v1 * gate4(GT + ((unsigned)row * 4096 + 2048 + col + 16));
        u32x2 w; w.x = pk2(v0[0], v0[1]); w.y = pk2(v0[2], v0[3]); *(u32x2*)(MIXED + ((unsigned)row * DM + col)) = w;
        w.x = pk2(v1[0], v1[1]); w.y = pk2(v1[2], v1[3]); *(u32x2*)(MIXED + ((unsigned)row * DM + col + 16)) = w;
    }
    EPI_FULL_TILE()
};
struct EpiResid {
    static constexpr bool PERM = false;
    const float* resP; const float* resS; float* dst;
    __device__ __forceinline__ void pair(const Unit& u, int ai, int bj, int m, int wr, int wc, int fr, int fq, f32x4 v0, f32x4 v1) const {
        const int row = u.pm * 256 + wr * 64 + fr + ai * 128 + m * 16; const unsigned col = u.pn * 256 + wc * 32 + 4 * fq + bj * 128;
        const float* rp = row < MP ? resP + (size_t)row * DM : resS + (size_t)(row - MP) * DM;
        *(f32x4*)(dst + ((unsigned)row * DM + col)) = v0 + *(const f32x4*)(rp + col) * ALPHA;
        *(f32x4*)(dst + ((unsigned)row * DM + col + 16)) = v1 + *(const f32x4*)(rp + col + 16) * ALPHA;
    }
    EPI_FULL_TILE()
};
struct EpiGateUp {
    static constexpr bool PERM = false;
    bf16_t* ACT;
    __device__ __forceinline__ void pair(const Unit& u, int ai, int bj, int m, int wr, int wc, int fr, int fq, f32x4 gt, f32x4 up) const {
        const int row = u.pm * 256 + wr * 64 + fr + ai * 128 + m * 16; const unsigned col = u.pn * 128 + wc * 16 + 4 * fq + bj * 64;
        u32x2 w; w.x = pk2(fsilu(gt[0]) * up[0], fsilu(gt[1]) * up[1]); w.y = pk2(fsilu(gt[2]) * up[2], fsilu(gt[3]) * up[3]);
        *(u32x2*)(ACT + ((unsigned)row * DFF + col)) = w;
    }
    EPI_FULL_TILE()
};

template <int MAP> __device__ __forceinline__ int srccol(int n) {
    if (MAP == 0) return n;
    if (MAP == 1) { if (n < 10240) return n; if (n < 20480) return n + 64; if (n < 20544) return n - 20480 + 10240; return -1; }
    const int pn = n >> 8, c = n & 255;
    return ((c & 16) ? DFF : 0) + 128 * pn + 64 * (c >> 7) + 16 * ((c >> 5) & 3) + (c & 15);
}
template <int MAP> __device__ __forceinline__ void tr_cvt(const float* __restrict__ src, int ldsrc, int K, bf16_t* __restrict__ dst, int Nd, int ldd = 0, int koff = 0) {
    if (ldd == 0) ldd = K;
    float* T = (float*)g_lds;
    const int tid = threadIdx.x, n4 = (tid & 15) * 4, kr = tid >> 4  , wn = tid >> 3  , k8 = (tid & 7) * 8;
    const int ntn = Nd / 64, ntiles = ntn * (K / 64);
    for (int tile = blockIdx.x; tile < ntiles; tile += gridDim.x) {
        const int n0 = (tile % ntn) * 64, k0 = (tile / ntn) * 64;
        const int sc = srccol<MAP>(n0 + n4);
#pragma unroll
        for (int h = 0; h < 2; ++h) {
            const int kk = kr + 32 * h;
            const f32x4 v = sc >= 0 ? __builtin_nontemporal_load((const f32x4*)(src + (size_t)(k0 + kk) * ldsrc + sc)) : (f32x4){0.f, 0.f, 0.f, 0.f};
            T[kk * 65 + n4 + 0] = v[0]; T[kk * 65 + n4 + 1] = v[1]; T[kk * 65 + n4 + 2] = v[2]; T[kk * 65 + n4 + 3] = v[3];
        }
        __syncthreads();
        u32x4 w;
        w.x = pk2(T[(k8 + 0) * 65 + wn], T[(k8 + 1) * 65 + wn]); w.y = pk2(T[(k8 + 2) * 65 + wn], T[(k8 + 3) * 65 + wn]);
        w.z = pk2(T[(k8 + 4) * 65 + wn], T[(k8 + 5) * 65 + wn]); w.w = pk2(T[(k8 + 6) * 65 + wn], T[(k8 + 7) * 65 + wn]);
        *(u32x4*)(dst + (size_t)(n0 + wn) * ldd + koff + k0 + k8) = w;
        __syncthreads();
    }
}

__device__ __forceinline__ void phase0(const Params& p) {
    const size_t gt = (size_t)blockIdx.x * 512 + threadIdx.x, gs = (size_t)gridDim.x * 512;
    bf16_t* __restrict__ XB = (bf16_t*)(p.ws + OFF_XB);
#pragma unroll 4
    for (size_t i = gt; i < (size_t)MT * 256; i += gs) {
        const size_t row = i >> 8; const int c8 = (int)(i & 255) * 8;
        const float* s = row < MP ? p.in[0] + row * DM + c8 : p.in[1] + (row - MP) * DM + c8;
        *(u32x4*)(XB + row * DM + c8) = cvt8(s);
    }
    tr_cvt<1>(p.in[6], NIN_SRC, DM, (bf16_t*)(p.ws + OFF_WIN), NIN);
    tr_cvt<0>(p.in[14], DM, SI, (bf16_t*)(p.ws + OFF_WSSD), DM);
    tr_cvt<0>(p.in[15], DM, DM, (bf16_t*)(p.ws + OFF_WATT), DM);
    if (blockIdx.x == 0) for (int i = threadIdx.x; i < 1024; i += 512) ((unsigned*)(p.ws + OFF_CTL))[i] = 0u;
    tr_cvt<0>(p.in[16], DM, DM, (bf16_t*)(p.ws + OFF_WO), DM);
}

__device__ __forceinline__ void unpack8(const u32x4 v, float (&f)[8]) { f[0] = lo2f(v.x); f[1] = hi2f(v.x); f[2] = lo2f(v.y); f[3] = hi2f(v.y); f[4] = lo2f(v.z); f[5] = hi2f(v.z); f[6] = lo2f(v.w); f[7] = hi2f(v.w); }
__device__ __forceinline__ void load8f(const float* s, float (&f)[8]) { const f32x4 a = *(const f32x4*)s, b = *(const f32x4*)(s + 4); f[0] = a[0]; f[1] = a[1]; f[2] = a[2]; f[3] = a[3]; f[4] = b[0]; f[5] = b[1]; f[6] = b[2]; f[7] = b[3]; }
__device__ __forceinline__ void conv_phase(const Params& p) {
    const size_t gt = (size_t)blockIdx.x * 512 + threadIdx.x, gs = (size_t)gridDim.x * 512;
    const bf16_t* __restrict__ XBC = (const bf16_t*)(p.ws + OFF_XBC); bf16_t* __restrict__ XC = (bf16_t*)(p.ws + OFF_XC);
    const float* cw = p.in[7]; const float* cb = p.in[8]; const float* sc = p.in[4];
    for (size_t it = gt; it < (size_t)576 * 768; it += gs) {
        const int cgi = (int)(it % 768), rb = (int)(it / 768), c = cgi * 8, r0 = rb * 16;
        float w0[8], w1[8], w2[8], w3[8], bb[8], h0[8], h1[8], h2[8];
        load8f(cw + c, w0); load8f(cw + CD + c, w1); load8f(cw + 2 * CD + c, w2); load8f(cw + 3 * CD + c, w3); load8f(cb + c, bb);
        const bool sstart = (r0 >= MP) && (((r0 - MP) & 63) == 0);
        if (r0 == 0) {
#pragma unroll
            for (int k = 0; k < 8; ++k) { h0[k] = 0.f; h1[k] = 0.f; h2[k] = 0.f; }
        } else if (sstart) {
            const int b = (r0 - MP) >> 6;
            load8f(sc + (size_t)(b * 3 + 0) * CD + c, h0); load8f(sc + (size_t)(b * 3 + 1) * CD + c, h1); load8f(sc + (size_t)(b * 3 + 2) * CD + c, h2);
        } else {
            unpack8(*(const u32x4*)(XBC + (size_t)(r0 - 3) * CD + c), h0); unpack8(*(const u32x4*)(XBC + (size_t)(r0 - 2) * CD + c), h1); unpack8(*(const u32x4*)(XBC + (size_t)(r0 - 1) * CD + c), h2);
        }
#pragma unroll 4
        for (int rr = 0; rr < 16; ++rr) {
            float cur[8], o[8];
            unpack8(*(const u32x4*)(XBC + (size_t)(r0 + rr) * CD + c), cur);
#pragma unroll
            for (int k = 0; k < 8; ++k) { o[k] = fsilu(bb[k] + h0[k] * w0[k] + h1[k] * w1[k] + h2[k] * w2[k] + cur[k] * w3[k]); h0[k] = h1[k]; h1[k] = h2[k]; h2[k] = cur[k]; }
            u32x4 w; w.x = pk2(o[0], o[1]); w.y = pk2(o[2], o[3]); w.z = pk2(o[4], o[5]); w.w = pk2(o[6], o[7]);
            *(u32x4*)(XC + (size_t)(r0 + rr) * CD + c) = w;
        }
    }
}

struct SsdRegs { u32x4 rb0, rb1, rc0, rc1, rx; float rdt; };
struct SsdCtx { const bf16_t* XC; const float* DT; bf16_t* Y; const float* st_in; float* out; int head, pq, g; float a_h, dskip; };
__device__ __forceinline__ void ssd_load(SsdRegs& r, const SsdCtx& c, int s, int tid) {
    const size_t R0 = (size_t)s * 64; const int lane = tid & 63, w = tid >> 6;
    { const int v = tid, j = v >> 4, n8 = (v & 15) * 8; r.rb0 = *(const u32x4*)(c.XC + (R0 + j) * CD + 4096 + c.g * 128 + n8); r.rc0 = *(const u32x4*)(c.XC + (R0 + j) * CD + 5120 + c.g * 128 + n8); }
    { const int v = tid + 512, j = v >> 4, n8 = (v & 15) * 8; r.rb1 = *(const u32x4*)(c.XC + (R0 + j) * CD + 4096 + c.g * 128 + n8); r.rc1 = *(const u32x4*)(c.XC + (R0 + j) * CD + 5120 + c.g * 128 + n8); }
    if (tid < 128) r.rx = *(const u32x4*)(c.XC + (R0 + (tid >> 1)) * CD + c.head * 64 + c.pq * 16 + (tid & 1) * 8);
    if (w == 7) r.rdt = c.DT[(R0 + lane) * 64 + c.head];
}
__device__ __forceinline__ void ssd_stage(const SsdRegs& r, int b, int tid) {
    bf16_t* Bn = (bf16_t*)(g_lds + b * 17408); bf16_t* Cn = (bf16_t*)(g_lds + 34816 + b * 17408); bf16_t* Xt = (bf16_t*)(g_lds + 69632 + b * 2304);
    { const int v = tid, j = v >> 4, n8 = (v & 15) * 8; *(u32x4*)(Bn + j * 136 + n8) = r.rb0; *(u32x4*)(Cn + j * 136 + n8) = r.rc0; }
    { const int v = tid + 512, j = v >> 4, n8 = (v & 15) * 8; *(u32x4*)(Bn + j * 136 + n8) = r.rb1; *(u32x4*)(Cn + j * 136 + n8) = r.rc1; }
    if (tid < 128) { const int j = tid >> 1, p8 = (tid & 1) * 8; const u32x4 rx = r.rx;
        Xt[(p8 + 0) * 72 + j] = (bf16_t)(rx.x & 0xffff); Xt[(p8 + 1) * 72 + j] = (bf16_t)(rx.x >> 16);
        Xt[(p8 + 2) * 72 + j] = (bf16_t)(rx.y & 0xffff); Xt[(p8 + 3) * 72 + j] = (bf16_t)(rx.y >> 16);
        Xt[(p8 + 4) * 72 + j] = (bf16_t)(rx.z & 0xffff); Xt[(p8 + 5) * 72 + j] = (bf16_t)(rx.z >> 16);
        Xt[(p8 + 6) * 72 + j] = (bf16_t)(rx.w & 0xffff); Xt[(p8 + 7) * 72 + j] = (bf16_t)(rx.w >> 16); }
}
__device__ __forceinline__ void ssd_scan(int b, float dt, float a_h, int lane) {
    float* f = (float*)(g_lds + 94464 + b * 1280); float x = dt * a_h;
    x += __builtin_bit_cast(float, __builtin_amdgcn_update_dpp(0, __builtin_bit_cast(int, x), 0x111, 0xf, 0xf, true));
    x += __builtin_bit_cast(float, __builtin_amdgcn_update_dpp(0, __builtin_bit_cast(int, x), 0x112, 0xf, 0xf, true));
    x += __builtin_bit_cast(float, __builtin_amdgcn_update_dpp(0, __builtin_bit_cast(int, x), 0x114, 0xf, 0xf, true));
    x += __builtin_bit_cast(float, __builtin_amdgcn_update_dpp(0, __builtin_bit_cast(int, x), 0x118, 0xf, 0xf, true));
    { const float t0 = __builtin_bit_cast(float, __builtin_amdgcn_readlane(__builtin_bit_cast(int, x), 15)), t1 = __builtin_bit_cast(float, __builtin_amdgcn_readlane(__builtin_bit_cast(int, x), 31)),
                  t2 = __builtin_bit_cast(float, __builtin_amdgcn_readlane(__builtin_bit_cast(int, x), 47));
      x += (lane >= 48) ? (t0 + t1) + t2 : (lane >= 32) ? t0 + t1 : (lane >= 16) ? t0 : 0.f; }
    const float last = __builtin_bit_cast(float, __builtin_amdgcn_readlane(__builtin_bit_cast(int, x), 63));
    f[lane] = x; f[64 + lane] = dt; f[128 + lane] = __expf(last - x) * dt; f[192 + lane] = __expf(x);
    if (lane == 63) f[256] = __expf(x);
}
__device__ __forceinline__ void ssd_step(int s, SsdRegs& r, const SsdCtx& c, f32x4 (&hacc)[2], f32x4 (&h0r)[2], int tid, const int V) {
    const int lane = tid & 63, w = tid >> 6, l15 = lane & 15, lq = lane >> 4;
    bf16_t* Xw = (bf16_t*)(g_lds + 74240); bf16_t* Mm = (bf16_t*)(g_lds + 76544);
    const size_t R0 = (size_t)s * 64; const int b = s & 1;
    const bf16_t* Bn = (const bf16_t*)(g_lds + b * 17408); const bf16_t* Cn = (const bf16_t*)(g_lds + 34816 + b * 17408); const bf16_t* Xt = (const bf16_t*)(g_lds + 69632 + b * 2304);
    const bf16_t* Hh = (const bf16_t*)(g_lds + 85760 + b * 4352); bf16_t* Hn = (bf16_t*)(g_lds + 85760 + (b ^ 1) * 4352);
    const float* fcs = (const float*)(g_lds + 94464 + b * 1280); const float* fdt = fcs + 64; const float* fwj = fcs + 128; const float* fec = fcs + 192;
    float rdt_scan = 0.f;
    if (s + 1 < 144) { ssd_stage(r, b ^ 1, tid); rdt_scan = r.rdt; }
    if (!(V & 1)) { if (s + 3 < 144) ssd_load(r, c, s + 3, tid); }
    if (w >= 4 && s + 1 >= 128 && s + 1 < 144) {
        const float* src = c.st_in + (((size_t)(s + 1 - 128) * 64 + c.head) * 64 + c.pq * 16) * 128;
#pragma unroll
        for (int tt = 0; tt < 2; ++tt) h0r[tt] = *(const f32x4*)(src + l15 * 128 + ((w - 4) * 2 + tt) * 16 + lq * 4);
    }
    if (!(V & 4)) {
        const int it = w >> 1;
#pragma unroll
        for (int tj = 0; tj < 2; ++tj) {
            const int jt = (w & 1) * 2 + tj;
            f32x4 acc = (f32x4){0.f, 0.f, 0.f, 0.f};
#pragma unroll
            for (int nk = 0; nk < 4; ++nk) {
                const bf16x8 A = *(const bf16x8*)(Cn + (it * 16 + l15) * 136 + nk * 32 + lq * 8);
                const bf16x8 B = *(const bf16x8*)(Bn + (jt * 16 + l15) * 136 + nk * 32 + lq * 8);
                acc = mfma16(B, A, acc);
            }
            const int i = it * 16 + l15, j0 = jt * 16 + lq * 4;
            const float csi = fcs[i]; const f32x4 csj = *(const f32x4*)(fcs + j0), dtj = *(const f32x4*)(fdt + j0);
            float v[4];
#pragma unroll
            for (int e = 0; e < 4; ++e) v[e] = (j0 + e <= i) ? acc[e] * __expf(csi - csj[e]) * dtj[e] : 0.f;
            u32x2 wv; wv.x = pk2(v[0], v[1]); wv.y = pk2(v[2], v[3]);
            *(u32x2*)(Mm + i * 72 + j0) = wv;
        }
        if (tid < 256) { const int pp = tid >> 4, j4 = (tid & 15) * 4; const u32x2 xv = *(const u32x2*)(Xt + pp * 72 + j4); const f32x4 wj = *(const f32x4*)(fwj + j4);
            u32x2 o; o.x = pk2(lo2f(xv.x) * wj[0], hi2f(xv.x) * wj[1]); o.y = pk2(lo2f(xv.y) * wj[2], hi2f(xv.y) * wj[3]); *(u32x2*)(Xw + pp * 72 + j4) = o; }
    }
    __syncthreads();
    if (V & 8) { if (w == 7 && s + 1 < 144) ssd_scan(b ^ 1, rdt_scan, c.a_h, lane); }
    else if (w < 4) {
        const int it = w;
        f32x4 accd = (f32x4){0.f, 0.f, 0.f, 0.f}, acco = accd;
#pragma unroll
        for (int jk = 0; jk < 2; ++jk) {
            const bf16x8 A = *(const bf16x8*)(Mm + (it * 16 + l15) * 72 + jk * 32 + lq * 8);
            const bf16x8 B = *(const bf16x8*)(Xt + l15 * 72 + jk * 32 + lq * 8);
            accd = mfma16(B, A, accd);
        }
#pragma unroll
        for (int nk = 0; nk < 4; ++nk) {
            const bf16x8 A = *(const bf16x8*)(Cn + (it * 16 + l15) * 136 + nk * 32 + lq * 8);
            const bf16x8 B = *(const bf16x8*)(Hh + l15 * 136 + nk * 32 + lq * 8);
            acco = mfma16(B, A, acco);
        }
        { const int i = it * 16 + l15; const float ec = fec[i]; float yv[4];
#pragma unroll
          for (int e = 0; e < 4; ++e) yv[e] = accd[e] + ec * acco[e] + c.dskip * bf2f(Xt[(lq * 4 + e) * 72 + i]);
          u32x2 wv; wv.x = pk2(yv[0], yv[1]); wv.y = pk2(yv[2], yv[3]);
          *(u32x2*)(c.Y + (R0 + i) * SI + c.head * 64 + c.pq * 16 + lq * 4) = wv; }
    } else {
        const float cdec = fcs[256];
        u32x2 fr[8];
        { const unsigned a0 = (unsigned)(size_t)Bn + (unsigned)(((lq * 8 + (l15 >> 2)) * 136 + (w - 4) * 32 + 4 * (l15 & 3)) * 2);
          asm volatile("ds_read_b64_tr_b16 %0, %8\n\tds_read_b64_tr_b16 %1, %8 offset:1088\n\tds_read_b64_tr_b16 %2, %8 offset:8704\n\tds_read_b64_tr_b16 %3, %8 offset:9792\n\t"
                       "ds_read_b64_tr_b16 %4, %8 offset:32\n\tds_read_b64_tr_b16 %5, %8 offset:1120\n\tds_read_b64_tr_b16 %6, %8 offset:8736\n\tds_read_b64_tr_b16 %7, %8 offset:9824\n\ts_waitcnt lgkmcnt(0)"
                       : "=&v"(fr[0]), "=&v"(fr[1]), "=&v"(fr[2]), "=&v"(fr[3]), "=&v"(fr[4]), "=&v"(fr[5]), "=&v"(fr[6]), "=&v"(fr[7]) : "v"(a0) : "memory"); }
#pragma unroll
        for (int tt = 0; tt < 2; ++tt) {
            hacc[tt] *= cdec;
#pragma unroll
            for (int jk = 0; jk < 2; ++jk) {
                const bf16x8 A = *(const bf16x8*)(Xw + l15 * 72 + jk * 32 + lq * 8);
                u32x4 wv; wv.x = fr[tt * 4 + jk * 2].x; wv.y = fr[tt * 4 + jk * 2].y; wv.z = fr[tt * 4 + jk * 2 + 1].x; wv.w = fr[tt * 4 + jk * 2 + 1].y;
                hacc[tt] = mfma16(__builtin_bit_cast(bf16x8, wv), A, hacc[tt]);
            }
        }
        if (s >= 127) {
            float* dst = (s == 127) ? c.out + O_SSMP + ((size_t)c.head * 64 + c.pq * 16) * 128
                                    : c.out + O_SSMS + (((size_t)(s - 128) * 64 + c.head) * 64 + c.pq * 16) * 128;
#pragma unroll
            for (int tt = 0; tt < 2; ++tt) *(f32x4*)(dst + l15 * 128 + ((w - 4) * 2 + tt) * 16 + lq * 4) = hacc[tt];
            if (s + 1 < 144) { hacc[0] = h0r[0]; hacc[1] = h0r[1]; }
        }
#pragma unroll
        for (int tt = 0; tt < 2; ++tt) { u32x2 wv; wv.x = pk2(hacc[tt][0], hacc[tt][1]); wv.y = pk2(hacc[tt][2], hacc[tt][3]);
            *(u32x2*)(Hn + l15 * 136 + ((w - 4) * 2 + tt) * 16 + lq * 4) = wv; }
        if (!(V & 16)) { if (w == 7 && s + 1 < 144) ssd_scan(b ^ 1, rdt_scan, c.a_h, lane); }
    }
    __syncthreads();
}
__device__ __forceinline__ void ssd_phase(const Params& p, const int V) {
    const int tid = threadIdx.x, lane = tid & 63, w = tid >> 6, l15 = lane & 15, lq = lane >> 4;
    for (int item = blockIdx.x; item < 256; item += gridDim.x) {
        SsdCtx c; c.XC = (const bf16_t*)(p.ws + OFF_XC); c.DT = (const float*)(p.ws + OFF_DT); c.Y = (bf16_t*)(p.ws + OFF_Y); c.st_in = p.in[5]; c.out = p.out;
        c.head = item >> 2; c.pq = item & 3; c.g = c.head >> 3; c.a_h = -__expf(p.in[10][c.head]); c.dskip = p.in[11][c.head];
        SsdRegs r0, r1;
        r0.rx = (u32x4){0u, 0u, 0u, 0u}; r1.rx = r0.rx; r0.rdt = 0.f; r1.rdt = 0.f;
        f32x4 hacc[2], h0r[2]; hacc[0] = (f32x4){0.f, 0.f, 0.f, 0.f}; hacc[1] = hacc[0]; h0r[0] = hacc[0]; h0r[1] = hacc[0];
        __syncthreads();
        ssd_load(r0, c, 0, tid);
        ssd_load(r1, c, 1, tid);
        ssd_stage(r0, 0, tid);
        if (w == 7) ssd_scan(0, r0.rdt, c.a_h, lane);
        if (w >= 4) { bf16_t* Hh = (bf16_t*)(g_lds + 85760);
#pragma unroll
            for (int tt = 0; tt < 2; ++tt)
#pragma unroll
                for (int e = 0; e < 4; ++e) Hh[(lq * 4 + e) * 136 + ((w - 4) * 2 + tt) * 16 + l15] = 0; }
        ssd_load(r0, c, 2, tid);
        __syncthreads();
        for (int s = 0; s < 144; s += 2) {
            ssd_step(s, r1, c, hacc, h0r, tid, V);
            ssd_step(s + 1, r0, c, hacc, h0r, tid, V);
        }
    }
}

__device__ __forceinline__ int vt_addr(int d, int key) { return d * 64 + ((((key >> 2) ^ (d ^ (d >> 3))) & 15) << 2) + (key & 3); }
__device__ __forceinline__ void attn_phase(const Params& p) {
    int tid_ = threadIdx.x;
    const int tid = tid_, hw = tid >> 8, ht = tid & 255, lane = tid & 63, wq = (tid >> 6) & 3, l15 = lane & 15, lq = lane >> 4;
    unsigned char* hb = g_lds + hw * 36992;
    bf16_t* Ks = (bf16_t*)hb;
    bf16_t* Vs = (bf16_t*)(hb + 17408);
    float* bs = (float*)(hb + 34816);
    const bf16_t* Qg = (const bf16_t*)(p.ws + OFF_Q);
    bf16_t* ATT = (bf16_t*)(p.ws + OFF_ATT);
    const float scale = 0.08838834764831845f;
    for (int pi = blockIdx.x; pi < 1152; pi += gridDim.x) {
        const int u = pi * 2 + hw, head = u & 15;
        int qrow0, krow0; const bf16_t* Kg; const bf16_t* Vg; const float* Kf = nullptr; const float* Vf = nullptr;
        if (u < 2048) { const int n = u >> 4; qrow0 = n * 64; krow0 = n * 64 - 512; Kg = (const bf16_t*)(p.ws + OFF_KPB); Vg = (const bf16_t*)(p.ws + OFF_VPB); }
        else { const int b = (u - 2048) >> 4; qrow0 = MP + b * 64; krow0 = 0; Kg = (const bf16_t*)(p.ws + OFF_KSB) + (size_t)b * 576 * DM; Vg = (const bf16_t*)(p.ws + OFF_VSB) + (size_t)b * 576 * DM;
               Kf = p.in[2] + (size_t)b * 512 * DM; Vf = p.in[3] + (size_t)b * 512 * DM; }
        __syncthreads();
        for (int i = ht; i < 257; i += 256) bs[i] = p.in[13][head * 257 + i];
        bf16x8 Qf[4];
        { const bf16_t* qp = Qg + (size_t)(qrow0 + wq * 16 + l15) * DM + head * 128 + lq * 8;
#pragma unroll
          for (int ks = 0; ks < 4; ++ks) Qf[ks] = *(const bf16x8*)(qp + ks * 32); }
        float mrun = -INFINITY, lrun = 0.f;
        f32x4 o[8];
#pragma unroll
        for (int db = 0; db < 8; ++db) o[db] = (f32x4){0.f, 0.f, 0.f, 0.f};
        f32x4 raw[16];
#define ATT_LOAD(t_) do { const int kr_ = krow0 + (t_) * 64; if (kr_ >= 0) { \
            if (Kf != nullptr && (t_) < 8) { \
                _Pragma("unroll") for (int e = 0; e < 4; ++e) { const int v = ht + 256 * e; const size_t o_ = (size_t)(kr_ + (v >> 4)) * DM + head * 128 + (v & 15) * 8; \
                    raw[2 * e] = *(const f32x4*)(Kf + o_); raw[2 * e + 1] = *(const f32x4*)(Kf + o_ + 4); raw[8 + 2 * e] = *(const f32x4*)(Vf + o_); raw[9 + 2 * e] = *(const f32x4*)(Vf + o_ + 4); } \
            } else { \
                _Pragma("unroll") for (int e = 0; e < 4; ++e) { const int v = ht + 256 * e; const size_t o_ = (size_t)(kr_ + (v >> 4)) * DM + head * 128 + (v & 15) * 8; \
                    raw[e] = *(const f32x4*)(Kg + o_); raw[4 + e] = *(const f32x4*)(Vg + o_); } \
            } } } while (0)
        ATT_LOAD(8);
        for (int itl = 0; itl < 9; ++itl) {
            const int t = itl == 0 ? 8 : itl - 1;
            const bool valid = (krow0 + t * 64) >= 0;
            __syncthreads();
            if (valid) {
                u32x4 rk[4], rv[4];
                if (Kf != nullptr && t < 8) {
#pragma unroll
                    for (int e = 0; e < 4; ++e) { rk[e] = pack8(raw[2 * e], raw[2 * e + 1]); rv[e] = pack8(raw[8 + 2 * e], raw[9 + 2 * e]); }
                } else {
#pragma unroll
                    for (int e = 0; e < 4; ++e) { rk[e] = __builtin_bit_cast(u32x4, raw[e]); rv[e] = __builtin_bit_cast(u32x4, raw[4 + e]); }
                }
#pragma unroll
                for (int e = 0; e < 4; ++e) { const int v = ht + 256 * e; *(u32x4*)(Ks + (v >> 4) * 136 + (v & 15) * 8) = rk[e]; }
#pragma unroll
                for (int e = 0; e < 4; ++e) { const int v = ht + 256 * e; *(u32x4*)(Vs + (v >> 4) * 136 + (v & 15) * 8) = rv[e]; }
            }
            __syncthreads();
            if (itl + 1 < 9) ATT_LOAD(itl);
            if (valid) {
                f32x4 sc[4];
#pragma unroll
                for (int kt = 0; kt < 4; ++kt) { sc[kt] = (f32x4){0.f, 0.f, 0.f, 0.f};
#pragma unroll
                    for (int ks = 0; ks < 4; ++ks) { const bf16x8 A = *(const bf16x8*)(Ks + (kt * 16 + l15) * 136 + ks * 32 + lq * 8); sc[kt] = mfma16(A, Qf[ks], sc[kt]); } }
                const int qi = wq * 16 + l15;
                float tmax = -INFINITY;
#pragma unroll
                for (int kt = 0; kt < 4; ++kt)
#pragma unroll
                    for (int e = 0; e < 4; ++e) { const int j = t * 64 + kt * 16 + lq * 4 + e; int rel = qi - j + 512; rel = rel < -128 ? -128 : (rel > 128 ? 128 : rel);
                        const float sv = sc[kt][e] * scale + bs[rel + 128]; sc[kt][e] = sv; tmax = fmaxf(tmax, sv); }
                tmax = fmaxf(tmax, __shfl_xor(tmax, 16, 64)); tmax = fmaxf(tmax, __shfl_xor(tmax, 32, 64));
                const float mnew = fmaxf(mrun, tmax), alpha = __expf(mrun - mnew);
                float psum = 0.f;
#pragma unroll
                for (int kt = 0; kt < 4; ++kt)
#pragma unroll
                    for (int e = 0; e < 4; ++e) { const float pv = __expf(sc[kt][e] - mnew); sc[kt][e] = pv; psum += pv; }
                psum += __shfl_xor(psum, 16, 64); psum += __shfl_xor(psum, 32, 64);
                lrun = lrun * alpha + psum; mrun = mnew;
#pragma unroll
                for (int db = 0; db < 8; ++db) o[db] *= alpha;
                bf16x8 Bp[2];
#pragma unroll
                for (int k2 = 0; k2 < 2; ++k2) { u32x4 w; w.x = pk2(sc[2 * k2][0], sc[2 * k2][1]); w.y = pk2(sc[2 * k2][2], sc[2 * k2][3]); w.z = pk2(sc[2 * k2 + 1][0], sc[2 * k2 + 1][1]); w.w = pk2(sc[2 * k2 + 1][2], sc[2 * k2 + 1][3]);
                    Bp[k2] = __builtin_bit_cast(bf16x8, w); }
                { const unsigned va = (unsigned)(size_t)Vs + (unsigned)(((lq * 4 + (l15 >> 2)) * 136 + 4 * (l15 & 3)) * 2);
#pragma unroll
                  for (int k2 = 0; k2 < 2; ++k2) {
                    u32x2 f[16];
                    const unsigned vb = va + (unsigned)k2 * 8704u;
                    asm volatile("ds_read_b64_tr_b16 %0, %16\n\tds_read_b64_tr_b16 %1, %16 offset:4352\n\tds_read_b64_tr_b16 %2, %16 offset:32\n\tds_read_b64_tr_b16 %3, %16 offset:4384\n\t"
                                 "ds_read_b64_tr_b16 %4, %16 offset:64\n\tds_read_b64_tr_b16 %5, %16 offset:4416\n\tds_read_b64_tr_b16 %6, %16 offset:96\n\tds_read_b64_tr_b16 %7, %16 offset:4448\n\t"
                                 "ds_read_b64_tr_b16 %8, %16 offset:128\n\tds_read_b64_tr_b16 %9, %16 offset:4480\n\tds_read_b64_tr_b16 %10, %16 offset:160\n\tds_read_b64_tr_b16 %11, %16 offset:4512\n\t"
                                 "ds_read_b64_tr_b16 %12, %16 offset:192\n\tds_read_b64_tr_b16 %13, %16 offset:4544\n\tds_read_b64_tr_b16 %14, %16 offset:224\n\tds_read_b64_tr_b16 %15, %16 offset:4576\n\ts_waitcnt lgkmcnt(0)"
                                 : "=&v"(f[0]), "=&v"(f[1]), "=&v"(f[2]), "=&v"(f[3]), "=&v"(f[4]), "=&v"(f[5]), "=&v"(f[6]), "=&v"(f[7]),
                                   "=&v"(f[8]), "=&v"(f[9]), "=&v"(f[10]), "=&v"(f[11]), "=&v"(f[12]), "=&v"(f[13]), "=&v"(f[14]), "=&v"(f[15]) : "v"(vb) : "memory");
#pragma unroll
                    for (int db = 0; db < 8; ++db) { u32x4 w; w.x = f[2 * db].x; w.y = f[2 * db].y; w.z = f[2 * db + 1].x; w.w = f[2 * db + 1].y;
                        o[db] = mfma16(__builtin_bit_cast(bf16x8, w), Bp[k2], o[db]); }
                  } }
            }
        }
#undef ATT_LOAD
        const float inv = 1.0f / lrun;
        bf16_t* op = ATT + (size_t)(qrow0 + wq * 16 + l15) * DM + head * 128 + lq * 4;
#pragma unroll
        for (int db = 0; db < 8; ++db) { u32x2 w; w.x = pk2(o[db][0] * inv, o[db][1] * inv); w.y = pk2(o[db][2] * inv, o[db][3] * inv); *(u32x2*)(op + db * 16) = w; }
    }
}

__device__ __forceinline__ void norm_phase(const Params& p) {
    const int lane = threadIdx.x & 63, gw = blockIdx.x * 8 + (threadIdx.x >> 6), nw = gridDim.x * 8;
    bf16_t* Y = (bf16_t*)(p.ws + OFF_Y); const bf16_t* Z = (const bf16_t*)(p.ws + OFF_Z); const float* nwt = p.in[12];
    for (int item0 = gw; item0 < MT * 8; item0 += 4 * nw) {
        u32x4 yv[4], zv[4]; float wv[4][8];
#pragma unroll
        for (int k = 0; k < 4; ++k) { const int item = item0 + k * nw; if (item < MT * 8) { const size_t base = (size_t)(item >> 3) * SI + (item & 7) * 512 + lane * 8;
            yv[k] = *(const u32x4*)(Y + base); zv[k] = *(const u32x4*)(Z + base); load8f(nwt + (item & 7) * 512 + lane * 8, wv[k]); } }
#pragma unroll
        for (int k = 0; k < 4; ++k) { const int item = item0 + k * nw; if (item < MT * 8) { const size_t base = (size_t)(item >> 3) * SI + (item & 7) * 512 + lane * 8;
            float y[8], z[8]; unpack8(yv[k], y); unpack8(zv[k], z);
            float ss = 0.f;
#pragma unroll
            for (int q = 0; q < 8; ++q) { y[q] = y[q] * fsilu(z[q]); ss += y[q] * y[q]; }
#pragma unroll
            for (int off = 1; off < 64; off <<= 1) ss += __shfl_xor(ss, off, 64);
            const float rs = rsqrtf(ss * (1.0f / 512.0f) + 1e-5f);
            u32x4 w; w.x = pk2(y[0] * rs * wv[k][0], y[1] * rs * wv[k][1]); w.y = pk2(y[2] * rs * wv[k][2], y[3] * rs * wv[k][3]); w.z = pk2(y[4] * rs * wv[k][4], y[5] * rs * wv[k][5]); w.w = pk2(y[6] * rs * wv[k][6], y[7] * rs * wv[k][7]);
            *(u32x4*)(Y + base) = w; } }
    }
}

__device__ __forceinline__ void ln_phase(const float* src, const float* gam, const float* bet, float* dstf, bf16_t* dstb) {
    const int lane = threadIdx.x & 63, gw = blockIdx.x * 8 + (threadIdx.x >> 6), nw = gridDim.x * 8;
    for (int row0 = gw; row0 < MT; row0 += 2 * nw) {
        f32x4 v[2][8];
#pragma unroll
        for (int h = 0; h < 2; ++h) { const int row = row0 + h * nw; if (row < MT) { const float* s = src + (size_t)row * DM;
#pragma unroll
            for (int k = 0; k < 8; ++k) v[h][k] = *(const f32x4*)(s + (k * 64 + lane) * 4); } }
#pragma unroll
        for (int h = 0; h < 2; ++h) { const int row = row0 + h * nw; if (row < MT) {
            float sum = 0.f;
#pragma unroll
            for (int k = 0; k < 8; ++k) sum += (v[h][k][0] + v[h][k][1]) + (v[h][k][2] + v[h][k][3]);
#pragma unroll
            for (int off = 1; off < 64; off <<= 1) sum += __shfl_xor(sum, off, 64);
            const float mean = sum * (1.0f / 2048.0f);
            float q = 0.f;
#pragma unroll
            for (int k = 0; k < 8; ++k) { v[h][k] -= mean; q += (v[h][k][0] * v[h][k][0] + v[h][k][1] * v[h][k][1]) + (v[h][k][2] * v[h][k][2] + v[h][k][3] * v[h][k][3]); }
#pragma unroll
            for (int off = 1; off < 64; off <<= 1) q += __shfl_xor(q, off, 64);
            const float rs = rsqrtf(q * (1.0f / 2048.0f) + 1e-5f);
#pragma unroll
            for (int k = 0; k < 8; ++k) { const int c = (k * 64 + lane) * 4;
                const f32x4 o = v[h][k] * rs * *(const f32x4*)(gam + c) + *(const f32x4*)(bet + c);
                if (dstb) *(f32x4*)(dstf + (size_t)row * DM + c) = o; else __builtin_nontemporal_store(o, (f32x4*)(dstf + (size_t)row * DM + c));
                if (dstb) { u32x2 w; w.x = pk2(o[0], o[1]); w.y = pk2(o[2], o[3]); *(u32x2*)(dstb + (size_t)row * DM + c) = w; } } } }
    }
}

#define XB_TMO      128
#define XB_XCNT(j)  (256  + 64 * (j))
#define XB_XSUB(j)  (1280 + 64 * (j))
#define XB_XGEN(j)  (2304 + 64 * (j))
#define XB_TOP      3328
#define XB_TOPGEN   3392
#define XCD_BAR_WORDS 3456
#define XB_SPIN_CAP (1u << 18)
#define XB_LAS __attribute__((address_space(3)))
__device__ __forceinline__ unsigned xb_ld(unsigned* p)              { return __hip_atomic_load(p, __ATOMIC_RELAXED, __HIP_MEMORY_SCOPE_AGENT); }
__device__ __forceinline__ unsigned xb_add(unsigned* p, unsigned v) { return __hip_atomic_fetch_add(p, v, __ATOMIC_RELAXED, __HIP_MEMORY_SCOPE_AGENT); }
__device__ __forceinline__ unsigned xb_xcc_id() { return (unsigned)__builtin_amdgcn_s_getreg((3 << 11) | 20) & 0xFu; }
#define XB_SPIN(cond, bar) do { unsigned _sp = 0; while (cond) { __builtin_amdgcn_s_sleep(1); \
    if ((++_sp & 255u) == 0u) { if (xb_ld(&(bar)[XB_TMO])) break; if (_sp > XB_SPIN_CAP) { atomicAdd(&(bar)[XB_TMO], 1u); break; } } } } while (0)
struct XcdBarrier { unsigned* bar; unsigned x; volatile XB_LAS unsigned* st; };
__device__ __forceinline__ XcdBarrier xcd_barrier_post(unsigned* bar, volatile XB_LAS unsigned* st) {
    XcdBarrier b; b.bar = bar; b.x = xb_xcc_id(); b.st = st;
    if (threadIdx.x == 0) (void)xb_add(&bar[XB_XCNT(b.x)], 1u);
    return b;
}
__device__ __forceinline__ void xcd_barrier_complete(unsigned* bar, unsigned x, unsigned& nloc, unsigned& nx) {
    const unsigned G = gridDim.x * gridDim.y * gridDim.z;
    unsigned sum, cnt, mine, sp = 0u;
    for (;;) {
        sum = 0u; cnt = 0u; mine = 0u;
#pragma unroll
        for (unsigned j = 0; j < 16; ++j) { const unsigned c = xb_ld(&bar[XB_XCNT(j)]); sum += c; cnt += (c > 0u) ? 1u : 0u; mine = (j == x) ? c : mine; }
        if (sum == G) break;
        __builtin_amdgcn_s_sleep(1);
        if ((++sp & 255u) == 0u) { if (xb_ld(&bar[XB_TMO])) break; if (sp > XB_SPIN_CAP) { atomicAdd(&bar[XB_TMO], 1u); break; } }
    }
    nloc = mine > 0u ? mine : 1u; nx = cnt > 0u ? cnt : 1u;
}
__device__ __forceinline__ void xcd_barrier(const XcdBarrier& b) {
    asm volatile("s_waitcnt vmcnt(0)" ::: "memory");
    __syncthreads();
    if (threadIdx.x == 0) {
        unsigned* bar = b.bar;
        __builtin_amdgcn_s_waitcnt(0);
        unsigned nloc = b.st[0], nx = b.st[1];
        if (nloc == 0u) { xcd_barrier_complete(bar, b.x, nloc, nx); b.st[0] = nloc; b.st[1] = nx; }
        const unsigned old = xb_add(&bar[XB_XSUB(b.x)], 1u);
        const unsigned gen = old / nloc;
        if (old + 1u == (gen + 1u) * nloc) {
            __builtin_amdgcn_fence(__ATOMIC_RELEASE, "agent");
            asm volatile("s_waitcnt vmcnt(0)" ::: "memory");
            const unsigned og = xb_add(&bar[XB_TOP], 1u);
            const unsigned tg = og / nx;
            if (og + 1u == (tg + 1u) * nx) xb_add(&bar[XB_TOPGEN], 1u);
            else XB_SPIN(xb_ld(&bar[XB_TOPGEN]) == tg, bar);
            __builtin_amdgcn_fence(__ATOMIC_ACQUIRE, "agent");
            xb_add(&bar[XB_XGEN(b.x)], 1u);
            asm volatile("s_waitcnt vmcnt(0)" ::: "memory");
        } else {
            XB_SPIN(xb_ld(&bar[XB_XGEN(b.x)]) == gen, bar);
            __builtin_amdgcn_fence(__ATOMIC_ACQUIRE, "agent");
            asm volatile("s_waitcnt vmcnt(0)" ::: "memory");
        }
    }
    __syncthreads();
}

__global__ void __launch_bounds__(512, 2) mega(Params p) {
    const int lo = p.ph_lo, hi = p.ph_hi;
    PG8_LAS unsigned char* lds = (PG8_LAS unsigned char*)g_lds;
    const int G = gridDim.x, c = blockIdx.x;
    unsigned char* ws = p.ws;
#ifndef PHMASK
#define PHMASK 0x7ff
#endif
#define IN(k) (((PHMASK >> (k)) & 1) && lo <= (k) && (k) < hi)
    volatile XB_LAS unsigned* xst = (volatile XB_LAS unsigned*)(lds + 131072 + 512);
    if (threadIdx.x < 4) xst[threadIdx.x] = 0u;
    __syncthreads();
    const XcdBarrier xbar = xcd_barrier_post((unsigned*)(ws + OFF_BAR), xst);
#define SEAM(k) do { if (IN((k) + 1)) { if ((k) == 0) cg::this_grid().sync(); else xcd_barrier(xbar); } } while (0)
    if (IN(0)) { REPS(0) phase0(p); SEAM(0); }
    unsigned* ctl = (unsigned*)(ws + OFF_CTL);
    if (IN(1)) {
        pg8::Gemm g{(const bf16_t*)(ws + OFF_XB), (const bf16_t*)(ws + OFF_WIN), MT, NIN, DM}; pg8::TailOrder S; S.init(MT, NIN, DM, G, c, 0);
        EpiIn E{ws, p.out, p.in[9]};
        REPS(1) pg8::gemm_phase<EpiIn, pg8::TailOrder>(lds, g, S, E, p.out + O_YP, ctl + 0);
        SEAM(1);
    }
    if (IN(2)) { REPS(2) conv_phase(p); SEAM(2); }
#ifdef SSD_PROBE
    if (IN(3)) { for (int rep = 0; rep < 2; ++rep) ssd_phase(p, rep == 0 ? SSD_PROBE : 0); REPS(13) attn_phase(p); SEAM(3); }
#else
    if (IN(3)) { ssd_phase(p, 0); REPS(13) attn_phase(p); SEAM(3); }
#endif
    if (IN(4)) {
        norm_phase(p);
        __syncthreads();
        tr_cvt<2>(p.in[19], 2 * DFF, DM, (bf16_t*)(ws + OFF_WGU), 2 * DFF);
        tr_cvt<0>(p.in[20], DM, DFF, (bf16_t*)(ws + OFF_WDN), DM);
        SEAM(4);
    }
    if (IN(5)) {
        { pg8::Gemm g{(const bf16_t*)(ws + OFF_Y), (const bf16_t*)(ws + OFF_WSSD), MT, DM, SI}; pg8::TailOrder S; S.init(MT, DM, SI, G, c, 0);
#ifdef P5_OLD
          EpiSsdOut E{p.out + O_YP, (const bf16_t*)(ws + OFF_GT)};
#else
          EpiSsdOut E{(float*)(ws + OFF_XC), (const bf16_t*)(ws + OFF_GT)};
#endif
          pg8::gemm_phase<EpiSsdOut, pg8::TailOrder>(lds, g, S, E, p.out + O_YP, ctl + 128); }
        xcd_barrier(xbar);
        { pg8::Gemm g{(const bf16_t*)(ws + OFF_ATT), (const bf16_t*)(ws + OFF_WATT), MT, DM, DM}; pg8::TailOrder S; S.init(MT, DM, DM, G, c, 0);
#ifdef P5_OLD
          EpiAttOut E{p.out + O_YP, (const bf16_t*)(ws + OFF_GT), (bf16_t*)(ws + OFF_MIXED)};
#else
          EpiAttOut E{(const float*)(ws + OFF_XC), (const bf16_t*)(ws + OFF_GT), (bf16_t*)(ws + OFF_MIXED)};
#endif
          pg8::gemm_phase<EpiAttOut, pg8::TailOrder>(lds, g, S, E, p.out + O_YP, ctl + 640); }
        SEAM(5);
    }
    if (IN(6)) {
        pg8::Gemm g{(const bf16_t*)(ws + OFF_MIXED), (const bf16_t*)(ws + OFF_WO), MT, DM, DM}; pg8::TailOrder S; S.init(MT, DM, DM, G, c, 0);
        EpiResid E{p.in[0], p.in[1], p.out + O_YP};
        pg8::gemm_phase<EpiResid, pg8::TailOrder>(lds, g, S, E, (float*)(ws + OFF_GT), ctl + 256);
        SEAM(6);
    }
    if (IN(7)) { ln_phase(p.out + O_YP, p.in[17], p.in[18], (float*)(ws + OFF_H), (bf16_t*)(ws + OFF_HB)); SEAM(7); }
    if (IN(8)) {
        pg8::Gemm g{(const bf16_t*)(ws + OFF_HB), (const bf16_t*)(ws + OFF_WGU), MT, 2 * DFF, DM}; pg8::TailOrder S; S.init(MT, 2 * DFF, DM, G, c, 0);
        EpiGateUp E{(bf16_t*)(ws + OFF_ACT)};
        REPS(8) pg8::gemm_phase<EpiGateUp, pg8::TailOrder>(lds, g, S, E, p.out + O_YP, ctl + 384);
        SEAM(8);
    }
    if (IN(9)) {
        pg8::Gemm g{(const bf16_t*)(ws + OFF_ACT), (const bf16_t*)(ws + OFF_WDN), MT, DM, DFF}; pg8::TailOrder S; S.init(MT, DM, DFF, G, c, 0);
        EpiResid E{(const float*)(ws + OFF_H), (const float*)(ws + OFF_H) + (size_t)MP * DM, p.out + O_YP};
        pg8::gemm_phase<EpiResid, pg8::TailOrder>(lds, g, S, E, (float*)(ws + OFF_GT), ctl + 512);
        SEAM(9);
    }
    if (IN(10)) { ln_phase(p.out + O_YP, p.in[21], p.in[22], p.out + O_YP, nullptr); }
#undef IN
#undef SEAM
}

extern "C" void kernel_launch(void* const* d_in, const int* in_sizes, int n_in, void* d_out, int out_size, void* d_ws, size_t ws_size, hipStream_t stream) {
    static int grid = 0;
    if (grid == 0) {
        if (n_in != 23 || ws_size < WS_END) { fprintf(stderr, "kernel_launch: unexpected n_in %d or ws_size %zu (< %zu)\n", n_in, ws_size, (size_t)WS_END); grid = -1; return; }
        int dev = 0, cus = 0, per_cu = 0;
        hipGetDevice(&dev); hipDeviceGetAttribute(&cus, hipDeviceAttributeMultiprocessorCount, dev);
        if (hipFuncSetAttribute((const void*)mega, hipFuncAttributeMaxDynamicSharedMemorySize, LDS_BYTES) != hipSuccess) { fprintf(stderr, "kernel_launch: hipFuncSetAttribute failed\n"); grid = -1; return; }
        if (hipOccupancyMaxActiveBlocksPerMultiprocessor(&per_cu, (const void*)mega, 512, LDS_BYTES) != hipSuccess || per_cu < 1) { fprintf(stderr, "kernel_launch: occupancy query gave %d\n", per_cu); (void)hipGetLastError(); grid = -1; return; }
        grid = cus;
    }
    if (grid < 0) return;
    if (hipMemsetAsync((char*)d_ws + OFF_BAR, 0, XCD_BAR_WORDS * 4, stream) != hipSuccess) { fprintf(stderr, "kernel_launch: memset of the barrier words failed\n"); return; }
    Params p{};
    for (int i = 0; i < 23; ++i) p.in[i] = (const float*)d_in[i];
    p.out = (float*)d_out; p.ws = (unsigned char*)d_ws;
#if ONE_LAUNCH
    p.ph_lo = 0; p.ph_hi = NPH;
    void* args[] = {&p};
    hipError_t e = hipLaunchCooperativeKernel((const void*)mega, dim3(grid), dim3(512), args, LDS_BYTES, stream);
    if (e != hipSuccess) fprintf(stderr, "cooperative launch failed: %s (grid %d)\n", hipGetErrorString(e), grid);
#else
    for (int ph = 0; ph < NPH; ++ph) { p.ph_lo = ph; p.ph_hi = ph + 1; hipLaunchKernelGGL(mega, dim3(grid), dim3(512), LDS_BYTES, stream, p); }
#endif
}
```
